# Optimizing an MI355X kernel written in HIP

```python
import math
import jax, jax.numpy as jnp
from jax import lax
import numpy as np

D_MODEL = 4096
BATCH = 1
SEQ = 8192
DEPTH = 1

MEM_TOKENS = 256
HEAD_DIM = 128
MIX_WIDTH = D_MODEL
DIFF_HEADS = MIX_WIDTH // 2 // HEAD_DIM
DIFF_QK_DIM = HEAD_DIM // 2
DIFF_V_DIM = HEAD_DIM
SB_HEADS = MIX_WIDTH // 2 // HEAD_DIM
SB_DIM = HEAD_DIM
DIFF_WIDTH = DIFF_HEADS * DIFF_V_DIM
SB_WIDTH = SB_HEADS * SB_DIM
IN_WIDTH = 3 * DIFF_WIDTH + 3 * SB_WIDTH
XATTN_HEADS = 4
XATTN_DIM = HEAD_DIM
XATTN_WIDTH = XATTN_HEADS * XATTN_DIM
D_FF = 7 * D_MODEL // 2
ROPE_THETA = 500000.0
ROT_DIM = DIFF_QK_DIM // 4
Q_BLOCK = 128
NORM_EPS = 1e-6

kernel_name = "hymba_diff_stickbreaking_macaron_sandwich"


def rmsnorm(x, gain):
    xf = x.astype(jnp.float32)
    xf = xf * lax.rsqrt(jnp.mean(xf * xf, axis=-1, keepdims=True) + NORM_EPS)
    return xf.astype(x.dtype) * gain


def swiglu(x, w_gate, w_up, w_down):
    return (jax.nn.silu(x @ w_gate) * (x @ w_up)) @ w_down


def rope_cos_sin(positions):
    inv_freq = ROPE_THETA ** (-jnp.arange(0, ROT_DIM, 2, dtype=jnp.float32) / ROT_DIM)
    ang = positions.astype(jnp.float32)[..., None] * inv_freq
    return jnp.cos(ang)[:, None], jnp.sin(ang)[:, None]


def partial_rope(x, cos, sin):
    half = ROT_DIM // 2
    x1 = x[..., :half].astype(jnp.float32)
    x2 = x[..., half:ROT_DIM].astype(jnp.float32)
    rot = jnp.concatenate([x1 * cos - x2 * sin, x2 * cos + x1 * sin], axis=-1).astype(x.dtype)
    return jnp.concatenate([rot, x[..., ROT_DIM:]], axis=-1)


def to_blocks(q):
    b, h, s, d = q.shape
    return jnp.moveaxis(q.reshape(b, h, s // Q_BLOCK, Q_BLOCK, d), 2, 0)


def from_blocks(o):
    nb, b, h, qb, d = o.shape
    return jnp.moveaxis(o, 0, 2).reshape(b, h, nb * qb, d)


def diff_attention(q1, q2, k1, k2, v, lam):
    s_len = k1.shape[2]
    scale = DIFF_QK_DIM ** -0.5
    kpos = jnp.arange(s_len)

    def one_block(args):
        q1b, q2b, blk = args
        qpos = blk * Q_BLOCK + jnp.arange(Q_BLOCK)
        causal = kpos[None, :] <= qpos[:, None]

        def probs(qb, k):
            sc = jnp.einsum('bhqd,bhkd->bhqk', qb, k).astype(jnp.float32) * scale
            return jax.nn.softmax(jnp.where(causal, sc, -jnp.inf), axis=-1)

        w = probs(q1b, k1) - lam * probs(q2b, k2)
        return jnp.einsum('bhqk,bhkd->bhqd', w.astype(v.dtype), v)

    nb = s_len // Q_BLOCK
    out = lax.map(one_block, (to_blocks(q1), to_blocks(q2), jnp.arange(nb)))
    return from_blocks(out)


def stick_breaking_attention(q, k, v):
    s_len = k.shape[2]
    scale = SB_DIM ** -0.5
    kpos = jnp.arange(s_len)

    def one_block(args):
        qb, blk = args
        qpos = blk * Q_BLOCK + jnp.arange(Q_BLOCK)
        strict = kpos[None, :] < qpos[:, None]
        z = jnp.einsum('bhqd,bhkd->bhqk', qb, k).astype(jnp.float32) * scale
        log_1m_beta = jnp.where(strict, jax.nn.log_sigmoid(-z), 0.0)
        suffix = lax.cumsum(log_1m_beta, axis=3, reverse=True) - log_1m_beta
        a = jnp.where(strict, jnp.exp(jax.nn.log_sigmoid(z) + suffix), 0.0)
        return jnp.einsum('bhqk,bhkd->bhqd', a.astype(v.dtype), v)

    nb = s_len // Q_BLOCK
    out = lax.map(one_block, (to_blocks(q), jnp.arange(nb)))
    return from_blocks(out)


def token_mixer(hn, positions, w_in, w_out, lambda_q1, lambda_k1, lambda_q2, lambda_k2,
                diff_subln, sb_norm, lambda_init):
    b, s, _ = hn.shape
    proj = hn @ w_in
    dq, dk, dv, sq, sk, sv = jnp.split(proj, 6, axis=-1)
    heads = lambda t, h, d: t.reshape(b, s, h, d).transpose(0, 2, 1, 3)

    cos, sin = rope_cos_sin(positions)
    dq = dq.reshape(b, s, DIFF_HEADS, 2, DIFF_QK_DIM).transpose(0, 2, 1, 3, 4)
    dk = dk.reshape(b, s, DIFF_HEADS, 2, DIFF_QK_DIM).transpose(0, 2, 1, 3, 4)
    q1 = partial_rope(dq[..., 0, :], cos, sin)
    q2 = partial_rope(dq[..., 1, :], cos, sin)
    k1 = partial_rope(dk[..., 0, :], cos, sin)
    k2 = partial_rope(dk[..., 1, :], cos, sin)
    vd = heads(dv, DIFF_HEADS, DIFF_V_DIM)
    lam = (jnp.exp(jnp.sum(lambda_q1.astype(jnp.float32) * lambda_k1.astype(jnp.float32)))
           - jnp.exp(jnp.sum(lambda_q2.astype(jnp.float32) * lambda_k2.astype(jnp.float32)))
           + lambda_init)
    diff_out = diff_attention(q1, q2, k1, k2, vd, lam)
    diff_out = rmsnorm(diff_out, diff_subln) * (1.0 - lambda_init)

    sb_out = stick_breaking_attention(heads(sq, SB_HEADS, SB_DIM), heads(sk, SB_HEADS, SB_DIM),
                                      heads(sv, SB_HEADS, SB_DIM))
    sb_out = rmsnorm(sb_out, sb_norm)

    merged = jnp.concatenate([
        diff_out.transpose(0, 2, 1, 3).reshape(b, s, DIFF_WIDTH),
        sb_out.transpose(0, 2, 1, 3).reshape(b, s, SB_WIDTH)], axis=-1)
    return merged @ w_out


def memory_cross_attention(hn, mem_n, w_q, w_kv, w_o):
    b, s, _ = hn.shape
    q = (hn @ w_q).reshape(b, s, XATTN_HEADS, XATTN_DIM)
    k, v = jnp.split((mem_n @ w_kv).reshape(b, MEM_TOKENS, 2, XATTN_HEADS, XATTN_DIM), 2, axis=2)
    k, v = k[:, :, 0], v[:, :, 0]
    sc = jnp.einsum('bshd,bmhd->bhsm', q, k).astype(jnp.float32) * XATTN_DIM ** -0.5
    p = jax.nn.softmax(sc, axis=-1).astype(v.dtype)
    o = jnp.einsum('bhsm,bmhd->bshd', p, v).reshape(b, s, XATTN_WIDTH)
    return o @ w_o


def setup_inputs(seed: int = 0) -> dict:
    key = jax.random.key(seed)
    ks = jax.random.split(key, 32)
    L = DEPTH
    nrm = lambda k, shape, fan_in: jax.random.normal(k, shape, jnp.float32) * fan_in ** -0.5
    gain = lambda k, d: 1.0 + 0.02 * jax.random.normal(k, (L, d), jnp.float32)
    offsets = jax.random.randint(ks[2], (BATCH, 1), 0, 4096, dtype=jnp.int32)
    positions = offsets + jnp.arange(SEQ, dtype=jnp.int32)[None, :]
    return {
        "x": jax.random.normal(ks[0], (BATCH, SEQ, D_MODEL), jnp.float32),
        "mem": jax.random.normal(ks[1], (BATCH, MEM_TOKENS, D_MODEL), jnp.float32),
        "positions": positions,
        "ffn1_norm_pre": gain(ks[3], D_MODEL),
        "ffn1_norm_post": gain(ks[4], D_MODEL),
        "ffn1_w_gate": nrm(ks[5], (L, D_MODEL, D_FF), D_MODEL),
        "ffn1_w_up": nrm(ks[6], (L, D_MODEL, D_FF), D_MODEL),
        "ffn1_w_down": nrm(ks[7], (L, D_FF, D_MODEL), D_FF),
        "mix_norm_pre": gain(ks[8], D_MODEL),
        "mix_norm_post": gain(ks[9], D_MODEL),
        "w_in": nrm(ks[10], (L, D_MODEL, IN_WIDTH), D_MODEL),
        "w_out": nrm(ks[11], (L, MIX_WIDTH, D_MODEL), MIX_WIDTH),
        "lambda_q1": 0.1 * jax.random.normal(ks[12], (L, DIFF_QK_DIM), jnp.float32),
        "lambda_k1": 0.1 * jax.random.normal(ks[13], (L, DIFF_QK_DIM), jnp.float32),
        "lambda_q2": 0.1 * jax.random.normal(ks[14], (L, DIFF_QK_DIM), jnp.float32),
        "lambda_k2": 0.1 * jax.random.normal(ks[15], (L, DIFF_QK_DIM), jnp.float32),
        "diff_subln": gain(ks[16], DIFF_V_DIM),
        "sb_norm": gain(ks[17], SB_DIM),
        "xattn_norm_pre": gain(ks[18], D_MODEL),
        "xattn_norm_post": gain(ks[19], D_MODEL),
        "mem_norm": gain(ks[20], D_MODEL),
        "xattn_w_q": nrm(ks[21], (L, D_MODEL, XATTN_WIDTH), D_MODEL),
        "xattn_w_kv": nrm(ks[22], (L, D_MODEL, 2 * XATTN_WIDTH), D_MODEL),
        "xattn_w_o": nrm(ks[23], (L, XATTN_WIDTH, D_MODEL), XATTN_WIDTH),
        "ffn2_norm_pre": gain(ks[24], D_MODEL),
        "ffn2_norm_post": gain(ks[25], D_MODEL),
        "ffn2_w_gate": nrm(ks[26], (L, D_MODEL, D_FF), D_MODEL),
        "ffn2_w_up": nrm(ks[27], (L, D_MODEL, D_FF), D_MODEL),
        "ffn2_w_down": nrm(ks[28], (L, D_FF, D_MODEL), D_FF),
    }


def reference(x, mem, positions, ffn1_norm_pre, ffn1_norm_post, ffn1_w_gate, ffn1_w_up,
              ffn1_w_down, mix_norm_pre, mix_norm_post, w_in, w_out, lambda_q1, lambda_k1,
              lambda_q2, lambda_k2, diff_subln, sb_norm, xattn_norm_pre, xattn_norm_post,
              mem_norm, xattn_w_q, xattn_w_kv, xattn_w_o, ffn2_norm_pre, ffn2_norm_post,
              ffn2_w_gate, ffn2_w_up, ffn2_w_down):
    h = x
    for l in range(DEPTH):
        lambda_init = 0.8 - 0.6 * math.exp(-0.3 * l)
        y = swiglu(rmsnorm(h, ffn1_norm_pre[l]), ffn1_w_gate[l], ffn1_w_up[l], ffn1_w_down[l])
        h = h + 0.5 * rmsnorm(y, ffn1_norm_post[l])
        y = token_mixer(rmsnorm(h, mix_norm_pre[l]), positions, w_in[l], w_out[l],
                        lambda_q1[l], lambda_k1[l], lambda_q2[l], lambda_k2[l],
                        diff_subln[l], sb_norm[l], lambda_init)
        h = h + rmsnorm(y, mix_norm_post[l])
        y = memory_cross_attention(rmsnorm(h, xattn_norm_pre[l]), rmsnorm(mem, mem_norm[l]),
                                   xattn_w_q[l], xattn_w_kv[l], xattn_w_o[l])
        h = h + rmsnorm(y, xattn_norm_post[l])
        y = swiglu(rmsnorm(h, ffn2_norm_pre[l]), ffn2_w_gate[l], ffn2_w_up[l], ffn2_w_down[l])
        h = h + 0.5 * rmsnorm(y, ffn2_norm_post[l])
    return h
```

```cpp
#include <hip/hip_runtime.h>
#include <cstdio>
#include <cstdint>
#include <cmath>
#ifndef PG8_WGM
#define PG8_WGM 8
#endif
namespace pg8 {
#define PG8_LAS __attribute__((address_space(3)))
typedef unsigned short bf16_t;
typedef short bf16x8 __attribute__((ext_vector_type(8)));
typedef float f32x4 __attribute__((ext_vector_type(4)));
typedef unsigned u32x4 __attribute__((ext_vector_type(4)));
constexpr int BM = 256, BK = 64, HALF = 128, HTB = HALF * BK * 2  , STAGE_BYTES = 8 * HTB, NXCD = 8, WGM = PG8_WGM;

__host__ __device__ __forceinline__ int lds_byte(int r, int c) { const int st = (r >> 4) * 2 + (c >> 5), rr = r & 15, cc = c & 31, ob = rr * 64 + cc * 2; return st * 1024 + (ob ^ (((ob >> 9) & 1) << 5)); }
__host__ __device__ __forceinline__ void stage_rc(int b, int& R, int& C) { const int st = b / 1024, sb = b % 1024, swz = sb ^ (((sb >> 9) & 1) << 5); R = (st >> 1) * 16 + swz / 64; C = (st & 1) * 32 + (swz % 64) / 2; }
__host__ __device__ __forceinline__ int perm32(int rho) { const int n = rho >> 4, i = rho & 15; return 8 * (i >> 2) + 4 * n + (i & 3); }

struct Unit { int pm, pn; };
struct Gemm { const bf16_t* A; const bf16_t* Bt; int M, N, K; };

struct StaticOrder {
    int nM, nN, nwg, G, c;
    __host__ __device__ void init(int M, int N, int G_, int c_) { nM = M / BM; nN = N / BM; nwg = nM * nN; G = G_; c = c_; }
    __host__ __device__ bool next(int i, Unit& u) const {
        const long L = (long)i * G + c; if (L >= nwg) return false;
        int wgid = (int)L; { const int q = nwg / NXCD, r = nwg % NXCD, xcd = wgid % NXCD, off = wgid / NXCD; wgid = (xcd < r ? xcd * (q + 1) : r * (q + 1) + (xcd - r) * q) + off; }
        const int nig = WGM * nN, gid = wgid / nig, fm = gid * WGM, gsz = (nM - fm) < WGM ? (nM - fm) : WGM;
        u.pm = fm + ((wgid % nig) % gsz); u.pn = (wgid % nig) / gsz; return true;
    }
    __device__ __forceinline__ void a_ready(const Unit&) const {}
    __device__ __forceinline__ void done(const Unit&) const {}
};
__device__ __forceinline__ unsigned cvt_pk_bf16(float lo, float hi) { unsigned r; asm volatile("v_cvt_pk_bf16_f32 %0, %1, %2" : "=v"(r) : "v"(lo), "v"(hi)); return r; }

constexpr float LOG2E = 1.4426950408889634f;

struct EpiF32 {
    static constexpr bool PERM = false, AFTER_DRAIN = false;
    float* C; int ldc;
    __device__ __forceinline__ void operator()(const f32x4 (&acc)[2][2][4][2], const Unit& u, int wr, int wc, int fr, int fq) const {
        const int row0 = u.pm * BM + wr * 64 + fr, col0 = u.pn * BM + wc * 32 + 4 * fq;
#pragma unroll
        for (int ai = 0; ai < 2; ++ai)
#pragma unroll
            for (int m = 0; m < 4; ++m) { float* rowp = C + (size_t)(row0 + ai * HALF + m * 16) * ldc + col0;
#pragma unroll
                for (int bj = 0; bj < 2; ++bj)
#pragma unroll
                    for (int n = 0; n < 2; ++n) *(f32x4*)(rowp + bj * HALF + n * 16) = acc[ai][bj][m][n]; }
    }
};
struct EpiBf16S {
    static constexpr bool PERM = true, AFTER_DRAIN = false;
    bf16_t* O; int ldc; float sc; const float* rs;
    __device__ __forceinline__ void operator()(const f32x4 (&acc)[2][2][4][2], const Unit& u, int wr, int wc, int fr, int fq) const {
        const int row0 = u.pm * BM + wr * 64 + fr, col0 = u.pn * BM + wc * 32 + 8 * fq;
#pragma unroll
        for (int ai = 0; ai < 2; ++ai)
#pragma unroll
            for (int m = 0; m < 4; ++m) { bf16_t* rowp = O + (size_t)(row0 + ai * HALF + m * 16) * ldc + col0;
                const float scr = rs ? sc * rs[row0 + ai * HALF + m * 16] : sc;
#pragma unroll
                for (int bj = 0; bj < 2; ++bj) { const f32x4 v0 = acc[ai][bj][m][0] * scr, v1 = acc[ai][bj][m][1] * scr;
                    u32x4 w; w.x = cvt_pk_bf16(v0[0], v0[1]); w.y = cvt_pk_bf16(v0[2], v0[3]); w.z = cvt_pk_bf16(v1[0], v1[1]); w.w = cvt_pk_bf16(v1[2], v1[3]);
                    *(u32x4*)(rowp + bj * HALF) = w; } }
    }
};
struct EpiBf16SS {
    static constexpr bool PERM = true, AFTER_DRAIN = false;
    bf16_t* O; int ldc; float* SSP; float sc;
    __device__ __forceinline__ void operator()(const f32x4 (&acc)[2][2][4][2], const Unit& u, int wr, int wc, int fr, int fq) const {
        const int row0 = u.pm * BM + wr * 64 + fr, col0 = u.pn * BM + wc * 32 + 8 * fq;
#pragma unroll
        for (int ai = 0; ai < 2; ++ai)
#pragma unroll
            for (int m = 0; m < 4; ++m) { const int row = row0 + ai * HALF + m * 16; bf16_t* rowp = O + (size_t)row * ldc + col0; float ss = 0.f;
#pragma unroll
                for (int bj = 0; bj < 2; ++bj) { const f32x4 v0 = acc[ai][bj][m][0] * sc, v1 = acc[ai][bj][m][1] * sc;
                    ss += ((v0[0] * v0[0] + v0[1] * v0[1]) + (v0[2] * v0[2] + v0[3] * v0[3])) + ((v1[0] * v1[0] + v1[1] * v1[1]) + (v1[2] * v1[2] + v1[3] * v1[3]));
                    u32x4 w; w.x = cvt_pk_bf16(v0[0], v0[1]); w.y = cvt_pk_bf16(v0[2], v0[3]); w.z = cvt_pk_bf16(v1[0], v1[1]); w.w = cvt_pk_bf16(v1[2], v1[3]);
                    *(u32x4*)(rowp + bj * HALF) = w; }
                ss += __shfl_xor(ss, 16); ss += __shfl_xor(ss, 32);
                if (fq == 0) SSP[(size_t)row * 64 + u.pn * 4 + wc] = ss; }
    }
};
__device__ __forceinline__ float silu_mul(float g, float u) { const float s = __builtin_amdgcn_exp2f(-g * LOG2E); return g * __builtin_amdgcn_rcpf(1.0f + s) * u; }
struct EpiSwiGLU {
    static constexpr bool PERM = true, AFTER_DRAIN = false;
    bf16_t* O; int ldc; int blkM; float sc; int fp8out; const float* rs;
    __device__ __forceinline__ void operator()(const f32x4 (&acc)[2][2][4][2], const Unit& u, int wr, int wc, int fr, int fq) const {
        const int row0 = u.pm * BM + wr * 64 + fr, col0 = u.pn * HALF + wc * 32 + 8 * fq;
        const size_t rpitch = blkM ? (size_t)BK : (size_t)ldc, cbase = blkM ? (size_t)(col0 >> 6) * blkM * BK + (col0 & 63) : (size_t)col0;
#pragma unroll
        for (int ai = 0; ai < 2; ++ai)
#pragma unroll
            for (int m = 0; m < 4; ++m) { bf16_t* rowp = O + (size_t)(row0 + ai * HALF + m * 16) * rpitch + cbase;
                const float scr = rs ? sc * rs[row0 + ai * HALF + m * 16] : sc;
                const f32x4 g0 = acc[ai][0][m][0] * scr, g1 = acc[ai][0][m][1] * scr, u0 = acc[ai][1][m][0] * scr, u1 = acc[ai][1][m][1] * scr;
                if (fp8out) { typedef unsigned u32x2_ __attribute__((ext_vector_type(2))); u32x2_ w8;
                    int t0 = __builtin_amdgcn_cvt_pk_fp8_f32(silu_mul(g0[0], u0[0]), silu_mul(g0[1], u0[1]), 0, false); t0 = __builtin_amdgcn_cvt_pk_fp8_f32(silu_mul(g0[2], u0[2]), silu_mul(g0[3], u0[3]), t0, true);
                    int t1 = __builtin_amdgcn_cvt_pk_fp8_f32(silu_mul(g1[0], u1[0]), silu_mul(g1[1], u1[1]), 0, false); t1 = __builtin_amdgcn_cvt_pk_fp8_f32(silu_mul(g1[2], u1[2]), silu_mul(g1[3], u1[3]), t1, true);
                    w8.x = (unsigned)t0; w8.y = (unsigned)t1;
                    *(u32x2_*)((unsigned char*)O + ((size_t)u.pn * blkM + (row0 + ai * HALF + m * 16)) * 128 + wc * 32 + 8 * fq) = w8; }
                else {
                u32x4 w; w.x = cvt_pk_bf16(silu_mul(g0[0], u0[0]), silu_mul(g0[1], u0[1])); w.y = cvt_pk_bf16(silu_mul(g0[2], u0[2]), silu_mul(g0[3], u0[3]));
                w.z = cvt_pk_bf16(silu_mul(g1[0], u1[0]), silu_mul(g1[1], u1[1])); w.w = cvt_pk_bf16(silu_mul(g1[2], u1[2]), silu_mul(g1[3], u1[3]));
                *(u32x4*)rowp = w; } }
    }
};
struct EpiProj {
    static constexpr bool PERM = true, AFTER_DRAIN = false;
    bf16_t* O; int ldc; const float* rope; const float* rs;
    __device__ __forceinline__ void operator()(const f32x4 (&acc)[2][2][4][2], const Unit& u, int wr, int wc, int fr, int fq) const {
        const int region = u.pn >> 3;
        const float sc = region == 0 ? 0.125f * LOG2E : (region == 3 ? 0.08838834764831845f * LOG2E : 1.0f);
        const bool rope_wave = (region < 2) && ((wc & 1) == 0);
        const int row0 = u.pm * BM + wr * 64 + fr;
        const float sgn = fq == 0 ? -1.0f : 1.0f;
        bf16_t* hp = O + ((size_t)(region * 16 + (u.pn & 7) * 2) * ldc) * 128 + wc * 32 + 8 * fq;
#pragma unroll
        for (int ai = 0; ai < 2; ++ai)
#pragma unroll
            for (int m = 0; m < 4; ++m) { const int row = row0 + ai * HALF + m * 16; bf16_t* rowp = hp + (size_t)row * 128;
                const float scr = sc * rs[row];
                f32x4 c0 = {1.f, 1.f, 1.f, 1.f}, c1 = c0, s0 = {0.f, 0.f, 0.f, 0.f}, s1 = s0;
                if (rope_wave && fq < 2) { const f32x4* rp = (const f32x4*)(rope + (size_t)row * 16); c0 = rp[0]; c1 = rp[1]; s0 = rp[2] * sgn; s1 = rp[3] * sgn; }
#pragma unroll
                for (int bj = 0; bj < 2; ++bj) { f32x4 v0 = acc[ai][bj][m][0], v1 = acc[ai][bj][m][1];
                    if (rope_wave) { f32x4 o0, o1;
#pragma unroll
                        for (int j = 0; j < 4; ++j) { o0[j] = __shfl_xor(v0[j], 16); o1[j] = __shfl_xor(v1[j], 16); }
                        v0 = v0 * c0 + o0 * s0; v1 = v1 * c1 + o1 * s1; }
                    v0 = v0 * scr; v1 = v1 * scr;
                    u32x4 w; w.x = cvt_pk_bf16(v0[0], v0[1]); w.y = cvt_pk_bf16(v0[2], v0[3]); w.z = cvt_pk_bf16(v1[0], v1[1]); w.w = cvt_pk_bf16(v1[2], v1[3]);
                    *(u32x4*)(rowp + (size_t)bj * ldc * 128) = w; }
                asm volatile("" ::: "memory"); }
    }
};
struct RowOrder {
    int nN, G, c;
    __device__ bool next(int i, Unit& u) const { const int L = i * G + c; if (L >= nN) return false; u.pm = 0; u.pn = L; return true; }
    __device__ __forceinline__ void a_ready(const Unit&) const {}
    __device__ __forceinline__ void done(const Unit&) const {}
};
template <class Epi, class Sched, bool ALIGN_EPI = false, bool SP2 = false, bool BLK = false, bool FP8 = false>
__device__ __forceinline__ void gemm_phase(PG8_LAS unsigned char* lds, const Gemm g, const Sched& S, const Epi& E) {
    int tid_ = threadIdx.x; asm volatile("" : "+v"(tid_));
    const int tid = tid_, wid = __builtin_amdgcn_readfirstlane(tid >> 6), lane = tid & 63, wr = wid >> 2, wc = wid & 3, fr = lane & 15, fq = lane >> 4;
    const int K = g.K, nt = K / (FP8 ? 2 * BK : BK);
    const int pitch = BLK ? BK : K;
    unsigned voffA[2], voffB[2];
#pragma unroll
    for (int i = 0; i < 2; ++i) { int R, C; stage_rc(tid * 16 + i * 8192, R, C); const int Rb = Epi::PERM ? ((R & ~31) + perm32(R & 31)) : R;
        voffA[i] = (unsigned)(R * pitch + C) * 2u; voffB[i] = (unsigned)(Rb * pitch + C) * 2u; }
    const size_t kstepA = BLK ? (size_t)g.M * BK * 2 : (size_t)(BK * 2), kstepB = BLK ? (size_t)g.N * BK * 2 : (size_t)(BK * 2);
    const size_t hstep = (size_t)HALF * pitch * 2;
    const size_t tstep = 2 * hstep;
    const unsigned ldsw = (unsigned)wid * 1024u;
    const int aoff = lds_byte(wr * 64 + fr, fq * 8), boff = lds_byte(wc * 32 + fr, fq * 8);
#define PG8_SA(b, h) (((b) * 2 + (h)) * HTB)
#define PG8_SB(b, h) ((4 + (b) * 2 + (h)) * HTB)
#define PG8_STAGE(bufoff, gbase, voff) do { _Pragma("unroll") for (int _i = 0; _i < 2; ++_i) \
        __builtin_amdgcn_global_load_lds((const unsigned*)((const char*)(gbase) + (voff)[_i]), (PG8_LAS unsigned*)(lds + (bufoff) + ldsw + _i * 8192), 16, 0, 0); } while (0)
#define PG8_LDA(dst, b, h) do { if constexpr (FP8) { _Pragma("unroll") for (int m = 0; m < 4; ++m) { const i32x4_ lo_ = *(const PG8_LAS i32x4_*)(lds + PG8_SA(b, h) + aoff + m * 2048), hi_ = *(const PG8_LAS i32x4_*)(lds + PG8_SA(b, h) + aoff + m * 2048 + 1024); \
            dst##8[m] = __builtin_shufflevector(lo_, hi_, 0, 1, 2, 3, 4, 5, 6, 7); } } \
        else { _Pragma("unroll") for (int m = 0; m < 4; ++m) _Pragma("unroll") for (int k = 0; k < 2; ++k) dst[m][k] = *(const PG8_LAS bf16x8*)(lds + PG8_SA(b, h) + aoff + m * 2048 + k * 1024); } } while (0)
#define PG8_LDB(dst, b, h) do { if constexpr (FP8) { _Pragma("unroll") for (int n = 0; n < 2; ++n) { const i32x4_ lo_ = *(const PG8_LAS i32x4_*)(lds + PG8_SB(b, h) + boff + n * 2048), hi_ = *(const PG8_LAS i32x4_*)(lds + PG8_SB(b, h) + boff + n * 2048 + 1024); \
            dst##8[n] = __builtin_shufflevector(lo_, hi_, 0, 1, 2, 3, 4, 5, 6, 7); } } \
        else { _Pragma("unroll") for (int n = 0; n < 2; ++n) _Pragma("unroll") for (int k = 0; k < 2; ++k) dst[n][k] = *(const PG8_LAS bf16x8*)(lds + PG8_SB(b, h) + boff + n * 2048 + k * 1024); } } while (0)
#define PG8_MMA(ai, bj, At, Bt) do { __builtin_amdgcn_s_setprio(1); _Pragma("unroll") for (int m = 0; m < 4; ++m) _Pragma("unroll") for (int n = 0; n < 2; ++n) { \
        if constexpr (FP8) asm volatile("v_mfma_scale_f32_16x16x128_f8f6f4 %0, %1, %2, %0, %3, %3 op_sel_hi:[0,0,0]" : "+v"(acc[ai][bj][m][n]) : "v"(Bt##8[n]), "v"(At##8[m]), "v"(0x7f7f7f7f)); \
        else { _Pragma("unroll") for (int k = 0; k < 2; ++k) acc[ai][bj][m][n] = __builtin_amdgcn_mfma_f32_16x16x32_bf16(Bt[n][k], At[m][k], acc[ai][bj][m][n], 0, 0, 0); } } \
        __builtin_amdgcn_s_setprio(0); } while (0)
#define PG8_WAIT_V(n) asm volatile("s_waitcnt vmcnt(" #n ")" ::: "memory")
#define PG8_WAIT_L(n) asm volatile("s_waitcnt lgkmcnt(" #n ")" ::: "memory")
#define PG8_BAR __builtin_amdgcn_s_barrier()
#define PG8_SCHED __builtin_amdgcn_sched_barrier(0)
    Unit cur, nxt; int ui = 0;
    if (!S.next(0, cur)) return;
    f32x4 acc[2][2][4][2];
#pragma unroll
    for (int a = 0; a < 2; ++a)
#pragma unroll
        for (int b = 0; b < 2; ++b)
#pragma unroll
            for (int m = 0; m < 4; ++m)
#pragma unroll
                for (int n = 0; n < 2; ++n) acc[a][b][m][n] = (f32x4){0.f, 0.f, 0.f, 0.f};
    typedef int i32x4_ __attribute__((ext_vector_type(4))); typedef int i32x8_ __attribute__((ext_vector_type(8)));
    bf16x8 At[4][2], B0[2][2], B1[2][2]; i32x8_ At8[4], B08[2], B18[2];
    const char* cA = (const char*)g.A + (size_t)cur.pm * tstep; const char* cB = (const char*)g.Bt + (size_t)cur.pn * tstep;
    S.a_ready(cur);
    if constexpr (SP2) {
        PG8_STAGE(PG8_SB(0, 0), cB, voffB); PG8_STAGE(PG8_SB(0, 1), cB + hstep, voffB); PG8_STAGE(PG8_SA(0, 0), cA, voffA); PG8_STAGE(PG8_SA(0, 1), cA + hstep, voffA);
        if (wr == 1) PG8_BAR;
        PG8_WAIT_V(2); PG8_BAR;
        PG8_STAGE(PG8_SB(1, 0), cB + kstepB, voffB); PG8_STAGE(PG8_SA(1, 0), cA + kstepA, voffA); PG8_STAGE(PG8_SB(1, 1), cB + hstep + kstepB, voffB);
        PG8_WAIT_V(6); PG8_BAR;
    } else {
        PG8_STAGE(PG8_SB(0, 0), cB, voffB); PG8_STAGE(PG8_SA(0, 0), cA, voffA); PG8_STAGE(PG8_SB(0, 1), cB + hstep, voffB); PG8_STAGE(PG8_SA(0, 1), cA + hstep, voffA);
        if (wr == 1) PG8_BAR;
        PG8_WAIT_V(4); PG8_BAR;
        PG8_STAGE(PG8_SB(1, 0), cB + kstepB, voffB); PG8_STAGE(PG8_SA(1, 0), cA + kstepA, voffA); PG8_STAGE(PG8_SB(1, 1), cB + hstep + kstepB, voffB);
        PG8_WAIT_V(6); PG8_BAR;
    }
    for (;;) {
        const bool has_next = S.next(ui + 1, nxt);
        const char* nA = has_next ? (const char*)g.A + (size_t)nxt.pm * tstep : cA; const char* nB = has_next ? (const char*)g.Bt + (size_t)nxt.pn * tstep : cB;
        for (int t = 0; t < nt; t += 2) {
            const bool last = (t == nt - 2);
            const char* a1 = cA + (size_t)(t + 1) * kstepA;
            const char* a2 = last ? nA : cA + (size_t)(t + 2) * kstepA; const char* b2 = last ? nB : cB + (size_t)(t + 2) * kstepB;
            const char* a3 = a2 + kstepA; const char* b3 = b2 + kstepB;
            if (last && has_next) S.a_ready(nxt);
            if constexpr (SP2) {
            PG8_LDB(B0, 0, 0); PG8_LDB(B1, 0, 1); PG8_SCHED; PG8_LDA(At, 0, 0); PG8_STAGE(PG8_SA(1, 1), a1 + hstep, voffA);
            PG8_WAIT_V(8); PG8_WAIT_L(0); PG8_BAR; PG8_MMA(0, 0, At, B0); PG8_MMA(0, 1, At, B1); PG8_BAR; PG8_SCHED;
            PG8_LDA(At, 0, 1); PG8_STAGE(PG8_SB(0, 0), b2, voffB); PG8_STAGE(PG8_SB(0, 1), b2 + hstep, voffB); PG8_STAGE(PG8_SA(0, 0), a2, voffA);
            PG8_WAIT_V(8); PG8_WAIT_L(0); PG8_BAR; PG8_MMA(1, 0, At, B0); PG8_MMA(1, 1, At, B1); PG8_BAR; PG8_SCHED;
            PG8_LDB(B0, 1, 0); PG8_LDB(B1, 1, 1); PG8_SCHED; PG8_LDA(At, 1, 0); PG8_STAGE(PG8_SA(0, 1), a2 + hstep, voffA);
            PG8_WAIT_V(8); PG8_WAIT_L(0); PG8_BAR; PG8_MMA(0, 0, At, B0); PG8_MMA(0, 1, At, B1); PG8_BAR; PG8_SCHED;
            PG8_LDA(At, 1, 1); PG8_STAGE(PG8_SB(1, 0), b3, voffB); PG8_STAGE(PG8_SB(1, 1), b3 + hstep, voffB); PG8_STAGE(PG8_SA(1, 0), a3, voffA);
            PG8_WAIT_V(8); PG8_WAIT_L(0); PG8_BAR; PG8_MMA(1, 0, At, B0); PG8_MMA(1, 1, At, B1); PG8_BAR; PG8_SCHED;
            } else {
            PG8_LDB(B0, 0, 0); PG8_SCHED; PG8_LDA(At, 0, 0); PG8_STAGE(PG8_SA(1, 1), a1 + hstep, voffA);
            PG8_WAIT_L(8); PG8_BAR; PG8_WAIT_L(0); PG8_MMA(0, 0, At, B0); PG8_BAR; PG8_SCHED;
            PG8_LDB(B1, 0, 1); PG8_STAGE(PG8_SB(0, 0), b2, voffB);
            PG8_BAR; PG8_WAIT_L(0); PG8_MMA(0, 1, At, B1); PG8_BAR;
            PG8_LDA(At, 0, 1); PG8_STAGE(PG8_SA(0, 0), a2, voffA);
            PG8_BAR; PG8_WAIT_L(0); PG8_MMA(1, 0, At, B0); PG8_BAR; PG8_SCHED;
            PG8_STAGE(PG8_SB(0, 1), b2 + hstep, voffB);
            PG8_WAIT_V(6); PG8_BAR; PG8_MMA(1, 1, At, B1); PG8_BAR;
            PG8_LDB(B0, 1, 0); PG8_SCHED; PG8_LDA(At, 1, 0); PG8_STAGE(PG8_SA(0, 1), a2 + hstep, voffA);
            PG8_WAIT_L(8); PG8_BAR; PG8_WAIT_L(0); PG8_MMA(0, 0, At, B0); PG8_BAR; PG8_SCHED;
            PG8_LDB(B1, 1, 1); PG8_STAGE(PG8_SB(1, 0), b3, voffB);
            PG8_BAR; PG8_WAIT_L(0); PG8_MMA(0, 1, At, B1); PG8_BAR;
            PG8_LDA(At, 1, 1); PG8_STAGE(PG8_SA(1, 0), a3, voffA);
            PG8_BAR; PG8_WAIT_L(0); PG8_MMA(1, 0, At, B0); PG8_BAR; PG8_SCHED;
            PG8_STAGE(PG8_SB(1, 1), b3 + hstep, voffB);
            PG8_WAIT_V(6); PG8_BAR; PG8_MMA(1, 1, At, B1); PG8_BAR;
            }
        }
        if constexpr (ALIGN_EPI) { if (wr == 0) PG8_BAR; }
        if constexpr (FP8) asm volatile("s_nop 15\n\ts_nop 15" ::: "memory");
        if constexpr (!Epi::AFTER_DRAIN) { int tz = tid; asm volatile("" : "+v"(tz));
            E(acc, cur, wr, wc, tz & 15, (tz & 63) >> 4); S.done(cur); }
        if (!has_next) break;
#pragma unroll
        for (int a = 0; a < 2; ++a)
#pragma unroll
            for (int b = 0; b < 2; ++b)
#pragma unroll
                for (int m = 0; m < 4; ++m)
#pragma unroll
                    for (int n = 0; n < 2; ++n) acc[a][b][m][n] = (f32x4){0.f, 0.f, 0.f, 0.f};
        cur = nxt; cA = nA; cB = nB; ++ui;
        if constexpr (ALIGN_EPI) { if (wr == 1) PG8_BAR; }
    }
    PG8_WAIT_V(0);
    if constexpr (!ALIGN_EPI) { if (wr == 0) PG8_BAR; }
    PG8_BAR;
    if constexpr (Epi::AFTER_DRAIN) { E.fused(acc, cur, wr, wc, fr, fq, lds, wid, lane); S.done(cur); }
#undef PG8_SA
#undef PG8_SB
#undef PG8_STAGE
#undef PG8_LDA
#undef PG8_LDB
#undef PG8_MMA
#undef PG8_WAIT_V
#undef PG8_WAIT_L
#undef PG8_BAR
#undef PG8_SCHED
}
}

namespace att {
#define ATT_LAS __attribute__((address_space(3)))
typedef unsigned short bf16_t;
typedef short bf16x8 __attribute__((ext_vector_type(8)));
typedef short s16x4 __attribute__((ext_vector_type(4)));
typedef float f32x16 __attribute__((ext_vector_type(16)));
typedef float f32x4 __attribute__((ext_vector_type(4)));
typedef unsigned u32x4 __attribute__((ext_vector_type(4)));
constexpr int SHM_K = 64 * 128 * 2, SHM_V = 64 * 128 * 2;
constexpr int NBUF = 4, SCR_OFF = 131072 + 1024;
constexpr int LDS_BYTES = SCR_OFF + 8 * 64 * 4 + 64;
constexpr float SB_EPS = 9.094947017729282e-13f;
#define ATT_KSWZ(row, colB) ((row) * 256 + ((colB) ^ (((row) & 7) << 4)))
#define ATT_SBAR() __builtin_amdgcn_sched_barrier(0)
__device__ __forceinline__ int crow(int r, int hi) { return (r & 3) + 8 * (r >> 2) + 4 * hi; }
__device__ __forceinline__ unsigned cvtpk(float lo, float hi) { unsigned r; asm volatile("v_cvt_pk_bf16_f32 %0, %1, %2" : "=v"(r) : "v"(lo), "v"(hi)); return r; }
__device__ __forceinline__ int v_st(int k, int c) { const int kk = (k & ~0xC) | ((k & 4) << 1) | ((k & 8) >> 1); return ((kk >> 3) * 4 + (c >> 5)) * 512 + ((kk & 7) * 32 + (c & 31)) * 2; }
__device__ __forceinline__ int v_rd_base(int lane) { return ((lane & 3) << 3) | (((lane >> 2) & 3) << 6) | (((lane >> 4) & 1) << 5) | (((lane >> 5) & 1) << 8); }
constexpr int v_rd_off(int d0, int ks, int half) { return d0 * 512 + ks * 4096 + half * 2048; }
template <int OFF> __device__ __forceinline__ s16x4 tr_read(int vb) { s16x4 r; asm volatile("ds_read_b64_tr_b16 %0, %1 offset:%2" : "=&v"(r) : "v"(vb), "i"(OFF) : "memory"); return r; }
template <int D0> __device__ __forceinline__ void pv_one(f32x16& od, int vb, bf16x8 pa0, bf16x8 pa1, bf16x8 pa2, bf16x8 pa3) {
  const s16x4 l0 = tr_read<v_rd_off(D0, 0, 0)>(vb), h0 = tr_read<v_rd_off(D0, 0, 1)>(vb), l1 = tr_read<v_rd_off(D0, 1, 0)>(vb), h1 = tr_read<v_rd_off(D0, 1, 1)>(vb);
  const s16x4 l2 = tr_read<v_rd_off(D0, 2, 0)>(vb), h2 = tr_read<v_rd_off(D0, 2, 1)>(vb), l3 = tr_read<v_rd_off(D0, 3, 0)>(vb), h3 = tr_read<v_rd_off(D0, 3, 1)>(vb);
  asm volatile("s_waitcnt lgkmcnt(0)" ::: "memory"); ATT_SBAR();
#define ATT_PK(L, H) (bf16x8){L[0], L[1], L[2], L[3], H[0], H[1], H[2], H[3]}
  od = __builtin_amdgcn_mfma_f32_32x32x16_bf16(pa0, ATT_PK(l0, h0), od, 0, 0, 0);
  od = __builtin_amdgcn_mfma_f32_32x32x16_bf16(pa1, ATT_PK(l1, h1), od, 0, 0, 0);
  od = __builtin_amdgcn_mfma_f32_32x32x16_bf16(pa2, ATT_PK(l2, h2), od, 0, 0, 0);
  od = __builtin_amdgcn_mfma_f32_32x32x16_bf16(pa3, ATT_PK(l3, h3), od, 0, 0, 0);
#undef ATT_PK
}
struct VFrag { s16x4 l0, h0, l1, h1, l2, h2, l3, h3; };
template <int D0> __device__ __forceinline__ void v_read8(VFrag& f, int vb) {
  f.l0 = tr_read<v_rd_off(D0, 0, 0)>(vb); f.h0 = tr_read<v_rd_off(D0, 0, 1)>(vb); f.l1 = tr_read<v_rd_off(D0, 1, 0)>(vb); f.h1 = tr_read<v_rd_off(D0, 1, 1)>(vb);
  f.l2 = tr_read<v_rd_off(D0, 2, 0)>(vb); f.h2 = tr_read<v_rd_off(D0, 2, 1)>(vb); f.l3 = tr_read<v_rd_off(D0, 3, 0)>(vb); f.h3 = tr_read<v_rd_off(D0, 3, 1)>(vb);
}
__device__ __forceinline__ void pv_mma(f32x16& od, const VFrag& f, bf16x8 pa0, bf16x8 pa1, bf16x8 pa2, bf16x8 pa3) {
#define ATT_PK(L, H) (bf16x8){L[0], L[1], L[2], L[3], H[0], H[1], H[2], H[3]}
  od = __builtin_amdgcn_mfma_f32_32x32x16_bf16(pa0, ATT_PK(f.l0, f.h0), od, 0, 0, 0);
  od = __builtin_amdgcn_mfma_f32_32x32x16_bf16(pa1, ATT_PK(f.l1, f.h1), od, 0, 0, 0);
  od = __builtin_amdgcn_mfma_f32_32x32x16_bf16(pa2, ATT_PK(f.l2, f.h2), od, 0, 0, 0);
  od = __builtin_amdgcn_mfma_f32_32x32x16_bf16(pa3, ATT_PK(f.l3, f.h3), od, 0, 0, 0);
#undef ATT_PK
}
__device__ __forceinline__ void pv_d0(f32x16 (&o)[4], int vb, bf16x8 pa0, bf16x8 pa1, bf16x8 pa2, bf16x8 pa3) {
  VFrag fa, fb;
  v_read8<0>(fa, vb); v_read8<1>(fb, vb);
  asm volatile("s_waitcnt lgkmcnt(8)" ::: "memory"); ATT_SBAR();
  pv_mma(o[0], fa, pa0, pa1, pa2, pa3); ATT_SBAR();
  v_read8<2>(fa, vb);
  asm volatile("s_waitcnt lgkmcnt(8)" ::: "memory"); ATT_SBAR();
  pv_mma(o[1], fb, pa0, pa1, pa2, pa3); ATT_SBAR();
  v_read8<3>(fb, vb);
  asm volatile("s_waitcnt lgkmcnt(8)" ::: "memory"); ATT_SBAR();
  pv_mma(o[2], fa, pa0, pa1, pa2, pa3); ATT_SBAR();
  asm volatile("s_waitcnt lgkmcnt(0)" ::: "memory"); ATT_SBAR();
  pv_mma(o[3], fb, pa0, pa1, pa2, pa3);
}
template <int OFF> __device__ __forceinline__ bf16x8 lds_read16(int a) { bf16x8 r; asm volatile("ds_read_b128 %0, %1 offset:%2" : "=&v"(r) : "v"(a), "i"(OFF) : "memory"); return r; }
template <int D0> __device__ __forceinline__ void qkt4(f32x16& p0, f32x16& p1, int kbase, const bf16x8 (&qr)[8], int r32, int hi) {
  bf16x8 kf[8];
#pragma unroll
  for (int i = 0; i < 4; ++i) { const int cb = ((D0 + i) * 16 + hi * 8) * 2, a = kbase + ATT_KSWZ(r32, cb); kf[2 * i] = lds_read16<0>(a); kf[2 * i + 1] = lds_read16<32 * 256>(a); }
  asm volatile("s_waitcnt lgkmcnt(4)" ::: "memory"); ATT_SBAR();
#pragma unroll
  for (int i = 0; i < 2; ++i) { p0 = __builtin_amdgcn_mfma_f32_32x32x16_bf16(kf[2 * i], qr[D0 + i], p0, 0, 0, 0); p1 = __builtin_amdgcn_mfma_f32_32x32x16_bf16(kf[2 * i + 1], qr[D0 + i], p1, 0, 0, 0); }
  ATT_SBAR(); asm volatile("s_waitcnt lgkmcnt(0)" ::: "memory"); ATT_SBAR();
#pragma unroll
  for (int i = 2; i < 4; ++i) { p0 = __builtin_amdgcn_mfma_f32_32x32x16_bf16(kf[2 * i], qr[D0 + i], p0, 0, 0, 0); p1 = __builtin_amdgcn_mfma_f32_32x32x16_bf16(kf[2 * i + 1], qr[D0 + i], p1, 0, 0, 0); }
}
template <int DLO, int DHI> __device__ __forceinline__ void qkt(f32x16& p0, f32x16& p1, const ATT_LAS char* Ks, const bf16x8 (&qr)[8], int r32, int hi) {
#pragma unroll
  for (int r = 0; r < 16; ++r) { p0[r] = 0.f; p1[r] = 0.f; }
  const int kbase = (int)(unsigned)(uintptr_t)Ks;
  qkt4<DLO>(p0, p1, kbase, qr, r32, hi);
  if (DHI - DLO == 8) qkt4<DLO + 4>(p0, p1, kbase, qr, r32, hi);
}
__device__ __forceinline__ void pack_p(const f32x16& p0, const f32x16& p1, bf16x8& pa0, bf16x8& pa1, bf16x8& pa2, bf16x8& pa3) {
#define ATT_PK4(P, BASE, OUT) do { unsigned a0 = cvtpk(P[BASE + 0], P[BASE + 1]), a1 = cvtpk(P[BASE + 2], P[BASE + 3]);   \
    unsigned b0 = cvtpk(P[BASE + 4], P[BASE + 5]), b1 = cvtpk(P[BASE + 6], P[BASE + 7]);                              \
    auto r0 = __builtin_amdgcn_permlane32_swap(a0, b0, false, false); auto r1 = __builtin_amdgcn_permlane32_swap(a1, b1, false, false); \
    u32x4 w = {r0[0], r1[0], r0[1], r1[1]}; OUT = __builtin_bit_cast(bf16x8, w); } while (0)
  ATT_PK4(p0, 0, pa0); ATT_PK4(p0, 8, pa1); ATT_PK4(p1, 0, pa2); ATT_PK4(p1, 8, pa3);
#undef ATT_PK4
}

__device__ __forceinline__ void pv_pre(VFrag& fa, VFrag& fb, int vb) { v_read8<0>(fa, vb); v_read8<1>(fb, vb); }
__device__ __forceinline__ void pv_post(f32x16 (&o)[4], VFrag& fa, VFrag& fb, int vb, bf16x8 pa0, bf16x8 pa1, bf16x8 pa2, bf16x8 pa3) {
  asm volatile("s_waitcnt lgkmcnt(0)" ::: "memory"); ATT_SBAR();
  pv_mma(o[0], fa, pa0, pa1, pa2, pa3); ATT_SBAR();
  v_read8<2>(fa, vb); ATT_SBAR();
  pv_mma(o[1], fb, pa0, pa1, pa2, pa3); ATT_SBAR();
  v_read8<3>(fb, vb);
  asm volatile("s_waitcnt lgkmcnt(8)" ::: "memory"); ATT_SBAR();
  pv_mma(o[2], fa, pa0, pa1, pa2, pa3); ATT_SBAR();
  asm volatile("s_waitcnt lgkmcnt(0)" ::: "memory"); ATT_SBAR();
  pv_mma(o[3], fb, pa0, pa1, pa2, pa3);
}

struct VHalf { s16x4 a0, b0, c0, e0, a1, b1, c1, e1, a2, b2, c2, e2, a3, b3, c3, e3; };
template <int KS0> __device__ __forceinline__ void v_read_half(VHalf& f, int vb) {
  f.a0 = tr_read<v_rd_off(0, KS0, 0)>(vb); f.b0 = tr_read<v_rd_off(0, KS0, 1)>(vb); f.c0 = tr_read<v_rd_off(0, KS0 + 1, 0)>(vb); f.e0 = tr_read<v_rd_off(0, KS0 + 1, 1)>(vb);
  f.a1 = tr_read<v_rd_off(1, KS0, 0)>(vb); f.b1 = tr_read<v_rd_off(1, KS0, 1)>(vb); f.c1 = tr_read<v_rd_off(1, KS0 + 1, 0)>(vb); f.e1 = tr_read<v_rd_off(1, KS0 + 1, 1)>(vb);
  f.a2 = tr_read<v_rd_off(2, KS0, 0)>(vb); f.b2 = tr_read<v_rd_off(2, KS0, 1)>(vb); f.c2 = tr_read<v_rd_off(2, KS0 + 1, 0)>(vb); f.e2 = tr_read<v_rd_off(2, KS0 + 1, 1)>(vb);
  f.a3 = tr_read<v_rd_off(3, KS0, 0)>(vb); f.b3 = tr_read<v_rd_off(3, KS0, 1)>(vb); f.c3 = tr_read<v_rd_off(3, KS0 + 1, 0)>(vb); f.e3 = tr_read<v_rd_off(3, KS0 + 1, 1)>(vb);
}
__device__ __forceinline__ void pv_half(f32x16 (&o)[4], const VHalf& f, bf16x8 pA, bf16x8 pB) {
#define ATT_PK(L, H) (bf16x8){L[0], L[1], L[2], L[3], H[0], H[1], H[2], H[3]}
  o[0] = __builtin_amdgcn_mfma_f32_32x32x16_bf16(pA, ATT_PK(f.a0, f.b0), o[0], 0, 0, 0); o[1] = __builtin_amdgcn_mfma_f32_32x32x16_bf16(pA, ATT_PK(f.a1, f.b1), o[1], 0, 0, 0);
  o[2] = __builtin_amdgcn_mfma_f32_32x32x16_bf16(pA, ATT_PK(f.a2, f.b2), o[2], 0, 0, 0); o[3] = __builtin_amdgcn_mfma_f32_32x32x16_bf16(pA, ATT_PK(f.a3, f.b3), o[3], 0, 0, 0);
  o[0] = __builtin_amdgcn_mfma_f32_32x32x16_bf16(pB, ATT_PK(f.c0, f.e0), o[0], 0, 0, 0); o[1] = __builtin_amdgcn_mfma_f32_32x32x16_bf16(pB, ATT_PK(f.c1, f.e1), o[1], 0, 0, 0);
  o[2] = __builtin_amdgcn_mfma_f32_32x32x16_bf16(pB, ATT_PK(f.c2, f.e2), o[2], 0, 0, 0); o[3] = __builtin_amdgcn_mfma_f32_32x32x16_bf16(pB, ATT_PK(f.c3, f.e3), o[3], 0, 0, 0);
#undef ATT_PK
}
__device__ __forceinline__ void pack_half(const f32x16& p, bf16x8& lo, bf16x8& hi8) {
#define ATT_PK4(P, BASE, OUT) do { unsigned a0 = cvtpk(P[BASE + 0], P[BASE + 1]), a1 = cvtpk(P[BASE + 2], P[BASE + 3]);   \
    unsigned b0 = cvtpk(P[BASE + 4], P[BASE + 5]), b1 = cvtpk(P[BASE + 6], P[BASE + 7]);                              \
    auto r0 = __builtin_amdgcn_permlane32_swap(a0, b0, false, false); auto r1 = __builtin_amdgcn_permlane32_swap(a1, b1, false, false); \
    u32x4 w = {r0[0], r1[0], r0[1], r1[1]}; OUT = __builtin_bit_cast(bf16x8, w); } while (0)
  ATT_PK4(p, 0, lo); ATT_PK4(p, 8, hi8);
#undef ATT_PK4
}

enum { M_SOFT_A = 0, M_SOFT_B = 1, M_SB = 2, M_DENSE = 3 };
template <int MODE>
__device__ __forceinline__ void attn_core(const bf16_t* __restrict__ Q0, int ldq, const bf16_t* __restrict__ Kb, const bf16_t* __restrict__ Vb, int ldk,
                                          int qpos0, int nt, ATT_LAS char* lds, f32x16 (&o)[4], int par) {
  constexpr bool SOFT = (MODE != M_SB), CAUSAL = (MODE == M_SOFT_A || MODE == M_SOFT_B), STRICT = (MODE == M_SB);
  constexpr int DLO = (MODE == M_SOFT_B) ? 4 : 0, DHI = (MODE == M_SOFT_A) ? 4 : 8;
  int tid_ = threadIdx.x; asm volatile("" : "+v"(tid_));
  const int tid = tid_, wid = __builtin_amdgcn_readfirstlane(tid >> 6), lane = tid & 63, r32 = lane & 31, hi = lane >> 5;
  ATT_LAS char* V_lds = lds; ATT_LAS char* K_lds = lds + NBUF * SHM_V;
  ATT_LAS float* wsf = (ATT_LAS float*)(lds + SCR_OFF) + wid * 64; ATT_LAS float* li_l = wsf; ATT_LAS float* al_l = wsf + 32;
#pragma unroll
  for (int d = 0; d < 4; ++d)
#pragma unroll
    for (int r = 0; r < 16; ++r) o[d][r] = 0.f;
  bf16x8 qr[8];
  { const bf16_t* Qw = Q0 + (size_t)(wid * 32 + r32) * ldq + hi * 8;
#pragma unroll
    for (int d0 = DLO; d0 < DHI; ++d0) qr[d0] = *(const bf16x8*)(Qw + d0 * 16); }
  const int ksrc = (tid >> 4) * ldk + (((tid & 15) ^ ((tid >> 4) & 7)) << 3);
  const int vkk = ((tid >> 7) << 3) | ((tid & 31) >> 2), vk = (vkk & ~0xC) | ((vkk & 4) << 1) | ((vkk & 8) >> 1);
  const int vsrc = vk * ldk + (((tid >> 5) & 3) << 5) + ((tid & 3) << 3);
  const unsigned ldsw = (unsigned)wid * 1024u;
  const int vb0 = (int)(unsigned)(uintptr_t)V_lds + v_rd_base(lane);
  const int wrow0 = qpos0 + wid * 32, trow = wrow0 + r32;
  float m_reg = -1e30f, l_reg = 0.f, R = 1.0f;
  ATT_LAS int* dflag = (ATT_LAS int*)(lds + SCR_OFF + 8 * 64 * 4) + (par & 1) * 8;
  bool wdone = false;
  if (STRICT && lane == 0) dflag[wid] = -1;
#define ATT_DMA(t) do { const bf16_t* kg_ = Kb + (size_t)(64 * (t)) * ldk + ksrc; const bf16_t* vg_ = Vb + (size_t)(64 * (t)) * ldk + vsrc; const int b_ = (t) & 3; \
    __builtin_amdgcn_global_load_lds((const unsigned*)kg_, (ATT_LAS unsigned*)(K_lds + b_ * SHM_K + ldsw), 16, 0, 0); \
    __builtin_amdgcn_global_load_lds((const unsigned*)(kg_ + 32 * ldk), (ATT_LAS unsigned*)(K_lds + b_ * SHM_K + ldsw + 8192), 16, 0, 0); \
    __builtin_amdgcn_global_load_lds((const unsigned*)vg_, (ATT_LAS unsigned*)(V_lds + b_ * SHM_V + ldsw), 16, 0, 0); \
    __builtin_amdgcn_global_load_lds((const unsigned*)(vg_ + 32 * ldk), (ATT_LAS unsigned*)(V_lds + b_ * SHM_V + ldsw + 8192), 16, 0, 0); } while (0)
  ATT_DMA(nt - 1); ATT_DMA(nt - 2); asm volatile("s_waitcnt vmcnt(0)" ::: "memory"); __syncthreads();
  for (int jj = nt - 1; jj >= 1; jj -= 2) {
   if (jj >= 3) { ATT_DMA(jj - 2); ATT_DMA(jj - 3); }
#ifdef ATT_STAGGER
   if (wid >= 4) __builtin_amdgcn_s_sleep(ATT_STAGGER);
#endif
#pragma unroll
   for (int sub = 0; sub < 2; ++sub) {
    const int j = jj - sub, b = j & 3, kbase = 64 * j;
    bool skip = false, needmask = false;
    if (CAUSAL) { skip = kbase > wrow0 + 31; needmask = kbase + 63 > wrow0; }
    if (STRICT) { skip = kbase >= wrow0 + 31; needmask = kbase + 63 >= wrow0; }
    if (!skip && !wdone) {
      f32x16 p0, p1; bf16x8 pa0, pa1, pa2, pa3;
      qkt<DLO, DHI>(p0, p1, K_lds + b * SHM_K, qr, r32, hi);
      VFrag vfa, vfb; VHalf vha, vhb; ATT_SBAR();
      if (SOFT) v_read_half<0>(vha, vb0 + b * SHM_V); else pv_pre(vfa, vfb, vb0 + b * SHM_V);
      ATT_SBAR();
      const int dd = trow - kbase - 4 * hi;
      if (SOFT) {
        if (CAUSAL && needmask) {
#pragma unroll
          for (int r = 0; r < 16; ++r) { const int cr = (r & 3) + 8 * (r >> 2); if (cr > dd) p0[r] = -INFINITY; if (cr + 32 > dd) p1[r] = -INFINITY; }
        }
        float pmax = p0[0];
#pragma unroll
        for (int r = 1; r < 16; ++r) pmax = fmaxf(pmax, p0[r]);
#pragma unroll
        for (int r = 0; r < 16; ++r) pmax = fmaxf(pmax, p1[r]);
        { auto rr = __builtin_amdgcn_permlane32_swap(__float_as_uint(pmax), __float_as_uint(pmax), false, false); pmax = fmaxf(__uint_as_float(rr[0]), __uint_as_float(rr[1])); }
        float mn, alpha;
        if (__builtin_expect(__all(pmax - m_reg <= 11.5f), 1)) { mn = m_reg; alpha = 1.f; }
        else { mn = fmaxf(m_reg, pmax); alpha = __builtin_amdgcn_exp2f(m_reg - mn); m_reg = mn; }
        if (__any(alpha < 1.f)) { if (hi == 0) al_l[r32] = alpha; asm volatile("s_waitcnt lgkmcnt(0)" ::: "memory");
#pragma unroll
          for (int r = 0; r < 16; ++r) { const float a = al_l[crow(r, hi)];
#pragma unroll
            for (int d = 0; d < 4; ++d) o[d][r] *= a; }
          asm volatile("s_waitcnt lgkmcnt(0)" ::: "memory"); }
#pragma unroll
        for (int r = 0; r < 16; ++r) p0[r] = __builtin_amdgcn_exp2f(p0[r] - mn);
        float ps = 0.f;
#pragma unroll
        for (int r = 0; r < 16; ++r) ps += p0[r];
        pack_half(p0, pa0, pa1);
        asm volatile("s_waitcnt lgkmcnt(0)" ::: "memory"); ATT_SBAR();
        pv_half(o, vha, pa0, pa1); ATT_SBAR();
        v_read_half<2>(vhb, vb0 + b * SHM_V); ATT_SBAR();
#pragma unroll
        for (int r = 0; r < 16; ++r) p1[r] = __builtin_amdgcn_exp2f(p1[r] - mn);
#pragma unroll
        for (int r = 0; r < 16; ++r) ps += p1[r];
        pack_half(p1, pa2, pa3);
        { auto rr = __builtin_amdgcn_permlane32_swap(__float_as_uint(ps), __float_as_uint(ps), false, false); ps = __uint_as_float(rr[0]) + __uint_as_float(rr[1]); }
        l_reg = l_reg * alpha + ps;
        asm volatile("s_waitcnt lgkmcnt(0)" ::: "memory"); ATT_SBAR();
        pv_half(o, vhb, pa2, pa3);
      } else {
        f32x16 q0, q1;
#pragma unroll
        for (int r = 0; r < 16; ++r) {
          { const float u = fmaxf(p0[r], -80.f), s = __builtin_amdgcn_exp2f(-u), rc = __builtin_amdgcn_rcpf(1.0f + s); p0[r] = rc; q0[r] = s * rc; }
          { const float u = fmaxf(p1[r], -80.f), s = __builtin_amdgcn_exp2f(-u), rc = __builtin_amdgcn_rcpf(1.0f + s); p1[r] = rc; q1[r] = s * rc; } }
        if (needmask) {
#pragma unroll
          for (int r = 0; r < 16; ++r) { const int cr = (r & 3) + 8 * (r >> 2);
            if (!(cr < dd)) { p0[r] = 0.f; q0[r] = 1.f; } if (!(cr + 32 < dd)) { p1[r] = 0.f; q1[r] = 1.f; } }
        }
        float tot[8];
#pragma unroll
        for (int c = 0; c < 4; ++c) { tot[c] = (q0[4 * c] * q0[4 * c + 1]) * (q0[4 * c + 2] * q0[4 * c + 3]); tot[4 + c] = (q1[4 * c] * q1[4 * c + 1]) * (q1[4 * c + 2] * q1[4 * c + 3]); }
        float run = R;
#pragma unroll
        for (int c = 7; c >= 0; --c) {
          auto rr = __builtin_amdgcn_permlane32_swap(__float_as_uint(tot[c]), __float_as_uint(tot[c]), false, false);
          const float Tlo = __uint_as_float(rr[0]), Thi = __uint_as_float(rr[1]);
          const float r1 = run, r0 = r1 * Thi;
          const float e3 = hi ? r1 : r0;
          if (c < 4) { const float e2 = e3 * q0[4 * c + 3], e1 = e2 * q0[4 * c + 2], e0 = e1 * q0[4 * c + 1];
            p0[4 * c + 3] *= e3; p0[4 * c + 2] *= e2; p0[4 * c + 1] *= e1; p0[4 * c] *= e0; }
          else { const int cc = c - 4; const float e2 = e3 * q1[4 * cc + 3], e1 = e2 * q1[4 * cc + 2], e0 = e1 * q1[4 * cc + 1];
            p1[4 * cc + 3] *= e3; p1[4 * cc + 2] *= e2; p1[4 * cc + 1] *= e1; p1[4 * cc] *= e0; }
          run = r0 * Tlo;
        }
        R = run;
      }
      if (!SOFT) { pack_p(p0, p1, pa0, pa1, pa2, pa3); pv_post(o, vfa, vfb, vb0 + b * SHM_V, pa0, pa1, pa2, pa3); }
      if (STRICT) { if (__all(R < SB_EPS)) { wdone = true; if (lane == 0) dflag[wid] = j; } }
    }
   }
    asm volatile("s_waitcnt vmcnt(0)" ::: "memory");
    __syncthreads();
    if (STRICT) { bool all = true;
#pragma unroll
      for (int w = 0; w < 8; ++w) all = all && (dflag[w] >= jj - 1);
      if (__builtin_amdgcn_readfirstlane((int)all)) break; }
  }
#undef ATT_DMA
  if (SOFT) {
    if (hi == 0) li_l[r32] = l_reg; asm volatile("s_waitcnt lgkmcnt(0)" ::: "memory");
#pragma unroll
    for (int r = 0; r < 16; ++r) { const float rl = __builtin_amdgcn_rcpf(li_l[crow(r, hi)]);
#pragma unroll
      for (int d = 0; d < 4; ++d) o[d][r] *= rl; }
    asm volatile("s_waitcnt lgkmcnt(0)" ::: "memory");
  }
}
template <bool NORM> __device__ __forceinline__ void store_rows(const f32x16 (&o)[4], const float* __restrict__ gain, float gscale, bf16_t* __restrict__ out, int ld, size_t cs, ATT_LAS char* lds) {
  int tl = threadIdx.x; asm volatile("" : "+v"(tl));
  const int lane = tl & 63, r32 = lane & 31, hi = lane >> 5, wid = __builtin_amdgcn_readfirstlane(tl >> 6);
  ATT_LAS char* stg = lds + (wid < 4 ? wid * 8192 : NBUF * SHM_V + (wid - 4) * 8192);
  float g[4] = {1.f, 1.f, 1.f, 1.f};
  if (NORM) {
#pragma unroll
    for (int d = 0; d < 4; ++d) g[d] = gain[32 * d + r32] * gscale; }
#pragma unroll
  for (int r = 0; r < 16; ++r) {
    float inv = 1.f;
    if (NORM) { float ss = (o[0][r] * o[0][r] + o[1][r] * o[1][r]) + (o[2][r] * o[2][r] + o[3][r] * o[3][r]);
      ss += __shfl_xor(ss, 1); ss += __shfl_xor(ss, 2); ss += __shfl_xor(ss, 4); ss += __shfl_xor(ss, 8); ss += __shfl_xor(ss, 16);
      inv = __builtin_amdgcn_rsqf(ss * (1.0f / 128.0f) + 1e-6f); }
    ATT_LAS bf16_t* rowp = (ATT_LAS bf16_t*)(stg + crow(r, hi) * 256) + r32;
#pragma unroll
    for (int d = 0; d < 4; ++d) { const float v = o[d][r] * inv * g[d]; rowp[32 * d] = (bf16_t)(cvtpk(v, v) & 0xffffu); }
  }
  asm volatile("s_waitcnt lgkmcnt(0)" ::: "memory");
#pragma unroll
  for (int k = 0; k < 8; ++k) { const int q = lane + 64 * k, row = q >> 4, piece = q & 15;
    const u32x4 w = *(const ATT_LAS u32x4*)(stg + row * 256 + piece * 16);
    *(u32x4*)(out + (size_t)row * ld + (size_t)(piece >> 3) * cs + (piece & 7) * 8) = w; }
  asm volatile("s_waitcnt lgkmcnt(0)" ::: "memory");
  __syncthreads();
}
}

constexpr int NWAVES = 8;
constexpr int S_ = 8192, D_ = 4096, FF_ = 14336, INW = 12288, MEMT = 256, XW = 512;
constexpr float NORM_EPS = 1e-6f;
#ifndef REP_P0
#define REP_P0 1
#endif
#ifndef REP_P1
#define REP_P1 1
#endif
#ifndef REP_P2
#define REP_P2 1
#endif
#ifndef REP_P3
#define REP_P3 1
#endif
#ifndef REP_P4
#define REP_P4 1
#endif
#ifndef REP_P6
#define REP_P6 1
#endif
#ifndef REP_P5
#define REP_P5 1
#endif
#ifndef CONV_P1
#define CONV_P1 0
#endif
#ifndef PG8_SP2V
#define PG8_SP2V true
#endif
#ifndef PG8_ALIGNV
#define PG8_ALIGNV true
#endif
#ifndef CONV_FP8
#define CONV_FP8 2
#endif
static_assert(CONV_FP8 >= 1, "the FFN2 gate|up GEMM reads the e4m3 rows the last pre-norm writes");
#ifndef STOP_AFTER
#define STOP_AFTER 99
#endif

constexpr size_t MiB = 1u << 20;
constexpr size_t WS_CTL = 0, CTL_ZERO_BYTES = 64 * 1024;
constexpr size_t WS_ROPE = 1 * MiB;
constexpr size_t WS_MEMN = 2 * MiB;
constexpr size_t WS_KV = 4 * MiB;
constexpr size_t WS_XQ = 5 * MiB;
constexpr size_t WS_XO = 13 * MiB;
constexpr size_t WS_SCR = 21 * MiB;
constexpr size_t WS_WQ = 53 * MiB, WS_WKV = 57 * MiB, WS_WO = 65 * MiB, WS_WOUT = 69 * MiB, WS_WIN = 101 * MiB;
constexpr size_t WS_WGU1 = 197 * MiB, WS_WD1 = 421 * MiB, WS_WGU2 = 533 * MiB, WS_WD2 = 757 * MiB;
constexpr size_t WS_XN = 869 * MiB;
constexpr size_t WS_MERGED = 933 * MiB;
constexpr size_t WS_Y = 997 * MiB;
constexpr size_t WS_XN8 = 1061 * MiB;
constexpr size_t WS_RSTD = 1 * MiB + 512 * 1024;
constexpr size_t WS_HID = 1125 * MiB;
constexpr size_t WS_SSP = 1349 * MiB;
constexpr size_t WS_END = 1351 * MiB;
constexpr int CW_BAR = 4096;

constexpr int RING_BYTES = 131072, MISC_OFF = RING_BYTES + 320, LDS_BYTES = 147456;

#define GAS __attribute__((address_space(1)))
#define LAS __attribute__((address_space(3)))
typedef unsigned short bf16;
typedef unsigned v4u __attribute__((ext_vector_type(4)));
typedef unsigned v2u __attribute__((ext_vector_type(2)));
typedef float f32x4 __attribute__((ext_vector_type(4)));
typedef float f32x2 __attribute__((ext_vector_type(2)));
typedef GAS unsigned gu32;

#define XB_TMO      128
#define XB_XCNT(j)  (256  + 64 * (j))
#define XB_XSUB(j)  (1280 + 64 * (j))
#define XB_XGEN(j)  (2304 + 64 * (j))
#define XB_TOP      3328
#define XB_TOPGEN   3392
#define XCD_BAR_WORDS 3456
#define XB_SPIN_CAP (1u << 18)

__device__ __forceinline__ unsigned xb_ld(unsigned* p)              { return __hip_atomic_load(p, __ATOMIC_RELAXED, __HIP_MEMORY_SCOPE_AGENT); }
__device__ __forceinline__ unsigned xb_add(unsigned* p, unsigned v) { return __hip_atomic_fetch_add(p, v, __ATOMIC_RELAXED, __HIP_MEMORY_SCOPE_AGENT); }
__device__ __forceinline__ unsigned xb_xcc_id() { return (unsigned)__builtin_amdgcn_s_getreg((3 << 11) | 20) & 0xFu; }
#define XB_SPIN(cond, bar) do { unsigned _sp = 0; while (cond) { __builtin_amdgcn_s_sleep(1); \
    if ((++_sp & 255u) == 0u) { if (xb_ld(&(bar)[XB_TMO])) break; if (_sp > XB_SPIN_CAP) { atomicAdd(&(bar)[XB_TMO], 1u); break; } } } } while (0)

struct XcdBarrier {
    unsigned* bar; unsigned x;
    volatile LAS unsigned* st;
};
__device__ __forceinline__ XcdBarrier xcd_barrier_post(unsigned* bar, volatile LAS unsigned* st) {
    XcdBarrier b; b.bar = bar; b.x = xb_xcc_id(); b.st = st;
    if (threadIdx.x == 0) (void)xb_add(&bar[XB_XCNT(b.x)], 1u);
    return b;
}
__device__ __forceinline__ void xcd_barrier_complete(unsigned* bar, unsigned x, unsigned& nloc, unsigned& nx) {
    const unsigned G = gridDim.x * gridDim.y * gridDim.z;
    unsigned sum, cnt, mine, sp = 0u;
    for (;;) {
        sum = 0u; cnt = 0u; mine = 0u;
#pragma unroll
        for (unsigned j = 0; j < 16; ++j) { const unsigned c = xb_ld(&bar[XB_XCNT(j)]); sum += c; cnt += (c > 0u) ? 1u : 0u; mine = (j == x) ? c : mine; }
        if (sum == G) break;
        __builtin_amdgcn_s_sleep(1);
        if ((++sp & 255u) == 0u) { if (xb_ld(&bar[XB_TMO])) break; if (sp > XB_SPIN_CAP) { atomicAdd(&bar[XB_TMO], 1u); break; } }
    }
    nloc = mine > 0u ? mine : 1u; nx = cnt > 0u ? cnt : 1u;
}
__device__ __forceinline__ void xcd_barrier(const XcdBarrier& b) {
    asm volatile("s_waitcnt vmcnt(0)" ::: "memory");
    __syncthreads();
    if (threadIdx.x == 0) {
        unsigned* bar = b.bar;
        __builtin_amdgcn_s_waitcnt(0);
        unsigned nloc = b.st[0], nx = b.st[1];
        if (nloc == 0u) { xcd_barrier_complete(bar, b.x, nloc, nx); b.st[0] = nloc; b.st[1] = nx; }
        const unsigned old = xb_add(&bar[XB_XSUB(b.x)], 1u);
        const unsigned gen = old / nloc;
        if (old + 1u == (gen + 1u) * nloc) {
            __builtin_amdgcn_fence(__ATOMIC_RELEASE, "agent");
            asm volatile("s_waitcnt vmcnt(0)" ::: "memory");
            const unsigned og = xb_add(&bar[XB_TOP], 1u);
            const unsigned tg = og / nx;
            if (og + 1u == (tg + 1u) * nx) xb_add(&bar[XB_TOPGEN], 1u);
            else XB_SPIN(xb_ld(&bar[XB_TOPGEN]) == tg, bar);
            __builtin_amdgcn_fence(__ATOMIC_ACQUIRE, "agent");
            xb_add(&bar[XB_XGEN(b.x)], 1u);
            asm volatile("s_waitcnt vmcnt(0)" ::: "memory");
        } else {
            XB_SPIN(xb_ld(&bar[XB_XGEN(b.x)]) == gen, bar);
            __builtin_amdgcn_fence(__ATOMIC_ACQUIRE, "agent");
            asm volatile("s_waitcnt vmcnt(0)" ::: "memory");
        }
    }
    __syncthreads();
}

__device__ __forceinline__ float wave_sum(float v) {
#pragma unroll
    for (int o = 1; o < 64; o <<= 1) v += __shfl_xor(v, o);
    return v;
}
__device__ __forceinline__ unsigned pkbf(float lo, float hi) { unsigned r; asm volatile("v_cvt_pk_bf16_f32 %0, %1, %2" : "=v"(r) : "v"(lo), "v"(hi)); return r; }

__device__ __forceinline__ void tr_item(const float* __restrict__ W, int K, int N, bf16* __restrict__ WT, int NT, int gmul, int goff, LAS unsigned* scr, int item, int lane, const float* __restrict__ gk) {
    { int t_ = threadIdx.x; asm volatile("" : "+v"(t_)); lane = t_ & 63; }
    const int nblk = N >> 6, kb = item / nblk, nb = item - kb * nblk, k0 = kb << 6, n0 = nb << 6;
    const int q = lane >> 4, c4 = (lane & 15) * 4;
    const float* src = W + (size_t)(k0 + 2 * q) * N + n0 + c4;
    f32x4 a[8], b[8]; f32x2 gg[8];
#pragma unroll
    for (int i = 0; i < 8; ++i) { a[i] = *(const f32x4*)(src + (size_t)(8 * i) * N); b[i] = *(const f32x4*)(src + (size_t)(8 * i + 1) * N); gg[i] = *(const f32x2*)(gk + k0 + 2 * q + 8 * i); }
#pragma unroll
    for (int i = 0; i < 8; ++i) { const int kp = 4 * i + q; const f32x4 av = a[i] * gg[i][0], bv = b[i] * gg[i][1];
        scr[(c4 + 0) * 33 + kp] = pkbf(av[0], bv[0]); scr[(c4 + 1) * 33 + kp] = pkbf(av[1], bv[1]);
        scr[(c4 + 2) * 33 + kp] = pkbf(av[2], bv[2]); scr[(c4 + 3) * 33 + kp] = pkbf(av[3], bv[3]); }
    asm volatile("s_waitcnt lgkmcnt(0)" ::: "memory");
    const int c = lane & 7;
#pragma unroll
    for (int jj = 0; jj < 8; ++jj) { const int n = (lane >> 3) + 8 * jj; const LAS unsigned* s = scr + n * 33 + 4 * c;
        v4u o; o.x = s[0]; o.y = s[1]; o.z = s[2]; o.w = s[3];
        const int nn = n0 + n; const int nrow = nn + gmul * (nn & ~127) + goff;
        *(v4u*)(WT + ((size_t)kb * NT + nrow) * 64 + 8 * c) = o; }
    asm volatile("s_waitcnt lgkmcnt(0)" ::: "memory");
}
struct ConvList { const float *wd1, *wkv, *win, *wout, *wq, *wo, *wg2, *wu2, *wd2; bf16 *WD1, *WKV, *WIN, *WOUT, *WQ, *WO, *WGU2, *WD2; const float *gwin, *gwq; };
constexpr int CI_GU = (D_ / 64) * (FF_ / 64), CI_DN = CI_GU, CI_IN = (D_ / 64) * (INW / 64), CI_OUT = (D_ / 64) * (D_ / 64), CI_Q = (D_ / 64) * (XW / 64), CI_KV = (D_ / 64) * (2 * XW / 64), CI_O = (XW / 64) * (D_ / 64);
constexpr int CE_WD1 = CI_DN, CE_WKV = CE_WD1 + CI_KV, CE_WIN = CE_WKV + CI_IN, CE_WOUT = CE_WIN + CI_OUT, CE_WQ = CE_WOUT + CI_Q, CE_WO = CE_WQ + CI_O, CE_WGU2 = CE_WO + 2 * CI_GU, CE_ALL = CE_WGU2 + CI_DN;
constexpr int CW_CONV = 2048;
struct ConvJob { const float* W; bf16* WT; const float* gk; int K, N, gmul, goff, item; };
__device__ __forceinline__ ConvJob conv_decode(const ConvList& L, int gi) {
    ConvJob j; j.gmul = 0; j.goff = 0; j.gk = nullptr; int r = gi;
    if (r < CE_WD1) { j.W = L.wd1; j.WT = L.WD1; j.K = FF_; j.N = D_; }
    else if (r < CE_WKV) { r -= CE_WD1; j.W = L.wkv; j.WT = L.WKV; j.K = D_; j.N = 2 * XW; }
    else if (r < CE_WIN) { r -= CE_WKV; j.W = L.win; j.WT = L.WIN; j.K = D_; j.N = INW; j.gk = L.gwin; }
    else if (r < CE_WOUT) { r -= CE_WIN; j.W = L.wout; j.WT = L.WOUT; j.K = D_; j.N = D_; }
    else if (r < CE_WQ) { r -= CE_WOUT; j.W = L.wq; j.WT = L.WQ; j.K = D_; j.N = XW; j.gk = L.gwq; }
    else if (r < CE_WO) { r -= CE_WQ; j.W = L.wo; j.WT = L.WO; j.K = XW; j.N = D_; }
    else if (r < CE_WO + CI_GU) { r -= CE_WO; j.W = L.wg2; j.WT = L.WGU2; j.K = D_; j.N = FF_; j.gmul = 1; }
    else if (r < CE_WGU2) { r -= CE_WO + CI_GU; j.W = L.wu2; j.WT = L.WGU2; j.K = D_; j.N = FF_; j.gmul = 1; j.goff = 128; }
    else { r -= CE_WGU2; j.W = L.wd2; j.WT = L.WD2; j.K = FF_; j.N = D_; }
    j.item = r; return j;
}
__device__ __forceinline__ void tr_load(const ConvJob& j, f32x4 (&a)[8], f32x4 (&b)[8], f32x2 (&gg)[8], int lane) {
    const int nblk = j.N >> 6, kb = j.item / nblk, nb = j.item - kb * nblk, k0 = kb << 6, n0 = nb << 6;
    const int q = lane >> 4, c4 = (lane & 15) * 4;
    const float* src = j.W + (size_t)(k0 + 2 * q) * j.N + n0 + c4;
#pragma unroll
    for (int i = 0; i < 8; ++i) { a[i] = __builtin_nontemporal_load((const f32x4*)(src + (size_t)(8 * i) * j.N)); b[i] = __builtin_nontemporal_load((const f32x4*)(src + (size_t)(8 * i + 1) * j.N)); }
    if (j.gk) {
#pragma unroll
        for (int i = 0; i < 8; ++i) gg[i] = *(const f32x2*)(j.gk + k0 + 2 * q + 8 * i); }
    else {
#pragma unroll
        for (int i = 0; i < 8; ++i) gg[i] = (f32x2){1.0f, 1.0f}; }
}
__device__ __forceinline__ void tr_finish(const ConvJob& j, const f32x4 (&a)[8], const f32x4 (&b)[8], const f32x2 (&gg)[8], LAS unsigned* scr, int lane) {
    const int nblk = j.N >> 6, kb = j.item / nblk, nb = j.item - kb * nblk, k0 = kb << 6, n0 = nb << 6;
    const int q = lane >> 4, c4 = (lane & 15) * 4;
#pragma unroll
    for (int i = 0; i < 8; ++i) { const int kp = 4 * i + q; const f32x4 av = a[i] * gg[i][0], bv = b[i] * gg[i][1];
        scr[(c4 + 0) * 33 + kp] = pkbf(av[0], bv[0]); scr[(c4 + 1) * 33 + kp] = pkbf(av[1], bv[1]);
        scr[(c4 + 2) * 33 + kp] = pkbf(av[2], bv[2]); scr[(c4 + 3) * 33 + kp] = pkbf(av[3], bv[3]); }
    asm volatile("s_waitcnt lgkmcnt(0)" ::: "memory");
    const int c = lane & 7;
#pragma unroll
    for (int jj = 0; jj < 8; ++jj) { const int n = (lane >> 3) + 8 * jj; const LAS unsigned* s = scr + n * 33 + 4 * c;
        v4u o; o.x = s[0]; o.y = s[1]; o.z = s[2]; o.w = s[3];
        const int nn = n0 + n; const int nrow = nn + j.gmul * (nn & ~127) + j.goff;
        __builtin_nontemporal_store(o, (v4u*)(j.WT + ((size_t)kb * (j.N << j.gmul) + nrow) * 64 + 8 * c)); }
    asm volatile("s_waitcnt lgkmcnt(0)" ::: "memory");
}
__device__ __forceinline__ unsigned pk4_fp8(float a, float b, float c, float d) { int w = __builtin_amdgcn_cvt_pk_fp8_f32(a, b, 0, false); w = __builtin_amdgcn_cvt_pk_fp8_f32(c, d, w, true); return (unsigned)w; }
__device__ __forceinline__ void tr_item8(const ConvJob& j, LAS unsigned* scr, int lane) {
    const int nblk = j.N >> 6, kb = j.item / nblk, nb = j.item - kb * nblk, k0 = kb << 6, n0 = nb << 6;
    const int q = lane >> 4, c4 = (lane & 15) * 4;
    const float* src = j.W + (size_t)(k0 + 4 * q) * j.N + n0 + c4;
    f32x4 r[4][4];
#pragma unroll
    for (int i = 0; i < 4; ++i)
#pragma unroll
        for (int e = 0; e < 4; ++e) r[i][e] = __builtin_nontemporal_load((const f32x4*)(src + (size_t)(16 * i + e) * j.N));
#pragma unroll
    for (int i = 0; i < 4; ++i) { const int kq = 4 * i + q;
#pragma unroll
        for (int jn = 0; jn < 4; ++jn) scr[(c4 + jn) * 17 + kq] = pk4_fp8(r[i][0][jn] * 256.0f, r[i][1][jn] * 256.0f, r[i][2][jn] * 256.0f, r[i][3][jn] * 256.0f); }
    asm volatile("s_waitcnt lgkmcnt(0)" ::: "memory");
    const int c = lane & 3;
#pragma unroll
    for (int jj = 0; jj < 4; ++jj) { const int n = (lane >> 2) + 16 * jj; const LAS unsigned* sp = scr + n * 17 + 4 * c;
        v4u o; o.x = sp[0]; o.y = sp[1]; o.z = sp[2]; o.w = sp[3];
        const int nn = n0 + n; const int nrow = nn + j.gmul * (nn & ~127) + j.goff;
        __builtin_nontemporal_store(o, (v4u*)((unsigned char*)j.WT + ((size_t)(kb >> 1) * (j.N << j.gmul) + nrow) * 128 + (kb & 1) * 64 + 16 * c)); }
    asm volatile("s_waitcnt lgkmcnt(0)" ::: "memory");
}
constexpr int CONV_CHUNK = 32, CONV_PER_WAVE = CONV_CHUNK / NWAVES;
static_assert(CE_WO % CONV_CHUNK == 0 && CE_WGU2 % CONV_CHUNK == 0, "a wave's items are all of one kind");
static_assert(CE_ALL % CONV_CHUNK == 0, "whole chunks");
__device__ __forceinline__ void conv_pull(const ConvList& L, gu32* ctr, int limit, gu32* stop, volatile LAS unsigned* slot, LAS unsigned* scr, int tid, int wave, int lane) {
    { int t_ = threadIdx.x; asm volatile("" : "+v"(t_)); tid = t_; lane = t_ & 63; }
    for (int iter = 0;; ++iter) {
        if (tid == 0) { unsigned b = 0xffffffffu;
            const bool halt = stop != nullptr && __hip_atomic_load(stop, __ATOMIC_RELAXED, __HIP_MEMORY_SCOPE_AGENT) != 0u;
            if (!halt && (int)__hip_atomic_load(ctr, __ATOMIC_RELAXED, __HIP_MEMORY_SCOPE_AGENT) < limit) b = __hip_atomic_fetch_add(ctr, (unsigned)CONV_CHUNK, __ATOMIC_RELAXED, __HIP_MEMORY_SCOPE_AGENT); slot[iter & 1] = b; }
        __syncthreads();
        const unsigned base = slot[iter & 1];
        if (base >= (unsigned)CE_ALL) break;
        const int g0 = (int)base + wave * CONV_PER_WAVE;
        if (CONV_FP8 && g0 >= CE_WO && g0 < (CONV_FP8 >= 2 ? CE_ALL : CE_WGU2)) {
#pragma unroll 1
            for (int k = 0; k < CONV_PER_WAVE; ++k) { const ConvJob j8 = conv_decode(L, g0 + k); tr_item8(j8, scr, lane); }
            continue; }
        f32x4 a0[8], b0[8], a1[8], b1[8]; f32x2 gg0[8], gg1[8];
        ConvJob j0 = conv_decode(L, g0), j1;
        tr_load(j0, a0, b0, gg0, lane);
#pragma unroll 1
        for (int k = 0; k < CONV_PER_WAVE; k += 2) {
            j1 = conv_decode(L, g0 + k + 1); tr_load(j1, a1, b1, gg1, lane);
            tr_finish(j0, a0, b0, gg0, scr, lane);
            if (k + 2 < CONV_PER_WAVE) { j0 = conv_decode(L, g0 + k + 2); tr_load(j0, a0, b0, gg0, lane); }
            tr_finish(j1, a1, b1, gg1, scr, lane);
        }
    }
    __syncthreads();
}
#define NR_LD(p, j) (((const f32x4*)((p) + 256 * (j)))[lane])
#define NR_FENCE() asm volatile("" ::: "memory")
template <bool HAS_Y, bool WRITE_H, bool WRITE_XN, bool RAW = false>
__device__ __forceinline__ void norm_row(const float* hin, const float* __restrict__ y, float cy, const float* __restrict__ g_post, float* hout,
                                         const float* __restrict__ g_pre, bf16* __restrict__ xn, size_t xcs, int lane, float* rstd = nullptr) {
    f32x4 hv[16];
    if (HAS_Y) {
    { int t_ = threadIdx.x; asm volatile("" : "+v"(t_)); lane = t_ & 63; }
        float ss = 0.f;
#pragma unroll
        for (int c = 0; c < 2; ++c) { f32x4 yv[8];
#pragma unroll
            for (int j = 0; j < 8; ++j) yv[j] = NR_LD(y, 8 * c + j);
#pragma unroll
            for (int j = 0; j < 8; ++j) ss += (yv[j][0] * yv[j][0] + yv[j][1] * yv[j][1]) + (yv[j][2] * yv[j][2] + yv[j][3] * yv[j][3]);
            NR_FENCE(); }
        const float ry = cy * __builtin_amdgcn_rsqf(wave_sum(ss) * (1.0f / 4096.0f) + NORM_EPS);
#pragma unroll
        for (int c = 0; c < 4; ++c) { f32x4 yv[4], gv[4];
#pragma unroll
            for (int j = 0; j < 4; ++j) { hv[4 * c + j] = NR_LD(hin, 4 * c + j); yv[j] = NR_LD(y, 4 * c + j); gv[j] = NR_LD(g_post, 4 * c + j); }
#pragma unroll
            for (int j = 0; j < 4; ++j) { hv[4 * c + j] = hv[4 * c + j] + (yv[j] * ry) * gv[j]; if (WRITE_H) ((f32x4*)(hout + 256 * (4 * c + j)))[lane] = hv[4 * c + j]; }
            NR_FENCE(); }
    } else {
#pragma unroll
        for (int c = 0; c < 2; ++c) {
#pragma unroll
            for (int j = 0; j < 8; ++j) hv[8 * c + j] = NR_LD(hin, 8 * c + j);
            NR_FENCE(); }
        if (WRITE_H) {
#pragma unroll
            for (int j = 0; j < 16; ++j) ((f32x4*)(hout + 256 * j))[lane] = hv[j]; }
    }
    if (WRITE_XN) {
        float ss = 0.f;
#pragma unroll
        for (int j = 0; j < 16; ++j) ss += (hv[j][0] * hv[j][0] + hv[j][1] * hv[j][1]) + (hv[j][2] * hv[j][2] + hv[j][3] * hv[j][3]);
        const float rh = __builtin_amdgcn_rsqf(wave_sum(ss) * (1.0f / 4096.0f) + NORM_EPS);
        if (RAW) { if (lane == 0) *rstd = rh; }
#pragma unroll
        for (int c = 0; c < 4; ++c) { f32x4 gv[4];
            if (!RAW) {
#pragma unroll
            for (int j = 0; j < 4; ++j) gv[j] = NR_LD(g_pre, 4 * c + j); }
#pragma unroll
            for (int j = 0; j < 4; ++j) { f32x4 v = hv[4 * c + j]; if (!RAW) v = (v * rh) * gv[j]; v2u w; w.x = pkbf(v[0], v[1]); w.y = pkbf(v[2], v[3]); *(v2u*)(xn + (size_t)(4 * (4 * c + j) + (lane >> 4)) * xcs + 4 * (lane & 15)) = w; }
            NR_FENCE(); }
    }
}

template <bool OUT32, bool FP8X>
__device__ __forceinline__ void norm_row2(bf16* xh, size_t xcs, const bf16* __restrict__ y, const float* __restrict__ ssp, float cy, const float* __restrict__ g_post, float* hout32,
                                          const float* __restrict__ g_pre, unsigned char* xn8, size_t x8cs, float* rstd, int lane) {
    { int t_ = threadIdx.x; asm volatile("" : "+v"(t_)); lane = t_ & 63; }
    const float ry = cy * __builtin_amdgcn_rsqf(wave_sum(ssp[lane]) * (1.0f / 4096.0f) + NORM_EPS);
    f32x4 hv[16];
#pragma unroll
    for (int c = 0; c < 4; ++c) { v2u yb[4], hb[4]; f32x4 gv[4];
#pragma unroll
        for (int j = 0; j < 4; ++j) { hb[j] = *(const v2u*)(xh + (size_t)(4 * (4 * c + j) + (lane >> 4)) * xcs + 4 * (lane & 15));
            yb[j] = ((const v2u*)(y + 256 * (4 * c + j)))[lane]; gv[j] = NR_LD(g_post, 4 * c + j); }
#pragma unroll
        for (int j = 0; j < 4; ++j) { const f32x4 yv = {__uint_as_float(yb[j].x << 16), __uint_as_float(yb[j].x & 0xffff0000u), __uint_as_float(yb[j].y << 16), __uint_as_float(yb[j].y & 0xffff0000u)};
            const f32x4 h0 = {__uint_as_float(hb[j].x << 16), __uint_as_float(hb[j].x & 0xffff0000u), __uint_as_float(hb[j].y << 16), __uint_as_float(hb[j].y & 0xffff0000u)};
            hv[4 * c + j] = h0 + (yv * ry) * gv[j];
            if (OUT32) ((f32x4*)(hout32 + 256 * (4 * c + j)))[lane] = hv[4 * c + j];
            else { v2u w; w.x = pkbf(hv[4 * c + j][0], hv[4 * c + j][1]); w.y = pkbf(hv[4 * c + j][2], hv[4 * c + j][3]); *(v2u*)(xh + (size_t)(4 * (4 * c + j) + (lane >> 4)) * xcs + 4 * (lane & 15)) = w; } }
        NR_FENCE(); }
    if (!OUT32) {
        float ss = 0.f;
#pragma unroll
        for (int j = 0; j < 16; ++j) ss += (hv[j][0] * hv[j][0] + hv[j][1] * hv[j][1]) + (hv[j][2] * hv[j][2] + hv[j][3] * hv[j][3]);
        const float rh = __builtin_amdgcn_rsqf(wave_sum(ss) * (1.0f / 4096.0f) + NORM_EPS);
        if (!FP8X) { if (lane == 0) *rstd = rh; }
        else {
#pragma unroll
        for (int c = 0; c < 4; ++c) { f32x4 gv[4];
#pragma unroll
            for (int j = 0; j < 4; ++j) gv[j] = NR_LD(g_pre, 4 * c + j);
#pragma unroll
            for (int j = 0; j < 4; ++j) { const f32x4 v = (hv[4 * c + j] * rh) * gv[j];
                *(unsigned*)(xn8 + (size_t)(2 * (4 * c + j) + (lane >> 5)) * x8cs + 4 * (lane & 31)) = pk4_fp8(v[0], v[1], v[2], v[3]); }
            NR_FENCE(); } }
    }
}
__device__ __forceinline__ void sincos_d(float ang, float& sn, float& cs) {
    const double a = (double)ang, k = __builtin_rint(a * 0.15915494309189535);
    double r = __builtin_fma(-k, 6.283185307179586, a); r = __builtin_fma(-k, 2.4492935982947064e-16, r);
    const double z = r * r;
    double sp = 1.0 / 1.0888869450418352e28;
    sp = sp * z - 1.0 / 1.5511210043330986e25;
    sp = sp * z + 1.0 / 2.5852016738884978e22;
    sp = sp * z - 1.0 / 5.109094217170944e19;
    sp = sp * z + 1.0 / 1.21645100408832e17;
    sp = sp * z - 1.0 / 3.55687428096e14;
    sp = sp * z + 1.0 / 1.307674368e12;
    sp = sp * z - 1.0 / 6.2270208e9;
    sp = sp * z + 1.0 / 3.99168e7;
    sp = sp * z - 1.0 / 362880.0;
    sp = sp * z + 1.0 / 5040.0;
    sp = sp * z - 1.0 / 120.0;
    sp = sp * z + 1.0 / 6.0;
    const double s = r - r * z * sp;
    double cp = 1.0 / 4.0329146112660565e26;
    cp = cp * z - 1.0 / 6.204484017332394e23;
    cp = cp * z + 1.0 / 1.1240007277776077e21;
    cp = cp * z - 1.0 / 2.43290200817664e18;
    cp = cp * z + 1.0 / 6.402373705728e15;
    cp = cp * z - 1.0 / 2.0922789888e13;
    cp = cp * z + 1.0 / 8.71782912e10;
    cp = cp * z - 1.0 / 4.790016e8;
    cp = cp * z + 1.0 / 3628800.0;
    cp = cp * z - 1.0 / 40320.0;
    cp = cp * z + 1.0 / 720.0;
    cp = cp * z - 1.0 / 24.0;
    cp = cp * z + 0.5;
    const double c = 1.0 - z * cp;
    sn = (float)s; cs = (float)c;
}

__device__ __forceinline__ const float* karg(int i) { int ii = i; asm volatile("" : "+s"(ii)); return ((const float* const __attribute__((address_space(4)))*)__builtin_amdgcn_kernarg_segment_ptr())[ii]; }
struct Args {
    const float* in[29]; const int* pos; float* out; unsigned char* ws; float inv_freq[8]; int pad0, pad1;
};

__global__ void __launch_bounds__(NWAVES * 64, 2) mega_fwd(Args args) {
    extern __shared__ __attribute__((aligned(16))) unsigned char lds_raw[];
    LAS unsigned char* lds = (LAS unsigned char*)lds_raw;
    volatile LAS unsigned* MISC = (volatile LAS unsigned*)(lds + MISC_OFF);
    const int tid = threadIdx.x, lane = tid & 63, wave = __builtin_amdgcn_readfirstlane(tid >> 6);
    const int G = gridDim.x, bid = blockIdx.x;
    unsigned char* ws = args.ws;
    gu32* ctl = (gu32*)(ws + WS_CTL);
    for (int u = tid; u < (LDS_BYTES - RING_BYTES) / 4; u += NWAVES * 64) ((LAS unsigned*)(lds + RING_BYTES))[u] = 0u;
    __syncthreads();
    XcdBarrier bar = xcd_barrier_post((unsigned*)(ctl + CW_BAR), MISC + 8);
#define GRID_BAR() xcd_barrier(bar)

#define KARG(i) karg(i)
    float* out = args.out;
    float* ROPE = (float*)(ws + WS_ROPE); bf16* MEMN = (bf16*)(ws + WS_MEMN); bf16* KV = (bf16*)(ws + WS_KV); bf16* XQ = (bf16*)(ws + WS_XQ); bf16* XO = (bf16*)(ws + WS_XO);
    float* SCR = (float*)(ws + WS_SCR);
    bf16* WQ = (bf16*)(ws + WS_WQ); bf16* WKV = (bf16*)(ws + WS_WKV); bf16* WO = (bf16*)(ws + WS_WO); bf16* WOUT = (bf16*)(ws + WS_WOUT); bf16* WIN = (bf16*)(ws + WS_WIN);
    bf16* WGU1 = (bf16*)(ws + WS_WGU1); bf16* WD1 = (bf16*)(ws + WS_WD1); bf16* WGU2 = (bf16*)(ws + WS_WGU2); bf16* WD2 = (bf16*)(ws + WS_WD2);
    bf16* XN = (bf16*)(ws + WS_XN); bf16* MERGED = (bf16*)(ws + WS_MERGED); bf16* Y = (bf16*)(ws + WS_Y); float* SSP = (float*)(ws + WS_SSP); bf16* HID = (bf16*)(ws + WS_HID); bf16* PROJ = (bf16*)(ws + WS_HID); unsigned char* XN8 = ws + WS_XN8; float* RSTD = (float*)(ws + WS_RSTD);
    const int gw = bid * NWAVES + wave, NGW = G * NWAVES;
    gu32* cctr = ctl + CW_CONV; LAS unsigned* cscr = (LAS unsigned*)(lds + wave * 8448); volatile LAS unsigned* cslot = MISC + 16;
#define CONV_LIST() const ConvList CL{KARG(7), KARG(22), KARG(10), KARG(11), KARG(21), KARG(23), KARG(26), KARG(27), KARG(28), WD1, WKV, WIN, WOUT, WQ, WO, WGU2, WD2, KARG(8), KARG(18)}
#define CONV_DRAIN(lim) do { CONV_LIST(); conv_pull(CL, cctr, (lim), nullptr, cslot, cscr, tid, wave, lane); } while (0)
#define CONV_HELP(k) do { CONV_LIST(); conv_pull(CL, cctr, CE_ALL, ctl + CW_CONV + 64 * (k), cslot, cscr, tid, wave, lane); } while (0)
#define CONV_RAISE(k) do { if (tid == 0) __hip_atomic_store(ctl + CW_CONV + 64 * (k), 1u, __ATOMIC_RELAXED, __HIP_MEMORY_SCOPE_AGENT); } while (0)

#pragma unroll 1
    for (int rep = 0; rep < REP_P0; ++rep) {
        LAS unsigned* scr = (LAS unsigned*)(lds + wave * 8448);
        for (int it = gw; it < 2 * CI_GU; it += NGW) {
            if (it < CI_GU) tr_item(KARG(5), D_, FF_, WGU1, 2 * FF_, 1, 0, scr, it, lane, KARG(3)); else tr_item(KARG(6), D_, FF_, WGU1, 2 * FF_, 1, 128, scr, it - CI_GU, lane, KARG(3));
        }
        for (int m = gw; m < S_; m += NGW) norm_row<false, false, true, true>(KARG(0) + (size_t)m * D_, nullptr, 0.f, nullptr, nullptr, nullptr, XN + (size_t)m * 64, (size_t)S_ * 64, lane, RSTD + m);
        for (int m = gw; m < MEMT; m += NGW) norm_row<false, false, true>(KARG(1) + (size_t)m * D_, nullptr, 0.f, nullptr, nullptr, KARG(20), MEMN + (size_t)m * 64, (size_t)MEMT * 64, lane);
        for (int e = bid * (NWAVES * 64) + tid; e < S_ * 8; e += G * NWAVES * 64) { const int t = e >> 3, i = e & 7;
            const float ang = (float)args.pos[t] * args.inv_freq[i]; float sn, cs; sincos_d(ang, sn, cs); ROPE[t * 16 + i] = cs; ROPE[t * 16 + 8 + i] = sn; }
    }
    GRID_BAR();

    { const int NG1 = (G == 256 && CONV_P1) ? 240 : G;
      if (bid < NG1) {
#pragma unroll 1
        for (int rep = 0; rep < REP_P1; ++rep)
        { pg8::Gemm g{XN, WGU1, S_, 2 * FF_, D_}; pg8::StaticOrder S; S.init(S_, 2 * FF_, NG1, bid); pg8::EpiSwiGLU E{HID, FF_, S_, 1.0f, 0, RSTD};
          pg8::gemm_phase<pg8::EpiSwiGLU, pg8::StaticOrder, PG8_ALIGNV, PG8_SP2V, true>(lds, g, S, E); }
        CONV_RAISE(1);
      } else CONV_HELP(1);
      CONV_DRAIN(CE_WKV); }
    GRID_BAR();
#pragma unroll 1
    for (int rep = 0; rep < REP_P2; ++rep)
    { pg8::Gemm g{HID, WD1, S_, D_, FF_}; pg8::StaticOrder S; S.init(S_, D_, G, bid); pg8::EpiBf16SS E{Y, D_, SSP, 1.0f};
      pg8::gemm_phase<pg8::EpiBf16SS, pg8::StaticOrder, PG8_ALIGNV, PG8_SP2V, true>(lds, g, S, E); }
    GRID_BAR();
    if (bid < 4 && G > 8) { pg8::Gemm g{MEMN, WKV, MEMT, 2 * XW, D_}; pg8::RowOrder S{(2 * XW) / 256, 4, bid}; pg8::EpiBf16S E{KV, 2 * XW, 1.0f, nullptr};
      pg8::gemm_phase<pg8::EpiBf16S, pg8::RowOrder, false, true, true>(lds, g, S, E); }
    else { const int nb = G > 8 ? G - 4 : G, b0 = G > 8 ? bid - 4 : bid;
#pragma unroll 1
      for (int rep = 0; rep < REP_P3; ++rep)
      for (int m = b0 * NWAVES + wave; m < S_; m += nb * NWAVES) norm_row2<false, false>(XN + (size_t)m * 64, (size_t)S_ * 64, Y + (size_t)m * D_, SSP + (size_t)m * 64, 0.5f, KARG(4), nullptr, nullptr, nullptr, 0, RSTD + m, lane); }
    if (STOP_AFTER <= 3) return;
    CONV_DRAIN(CE_WIN);
    GRID_BAR();
#pragma unroll 1
    for (int rep = 0; rep < REP_P4; ++rep)
    { pg8::Gemm g{XN, WIN, S_, INW, D_}; pg8::StaticOrder S; S.init(S_, INW, G, bid); pg8::EpiProj E{PROJ, S_, ROPE, RSTD};
      pg8::gemm_phase<pg8::EpiProj, pg8::StaticOrder, PG8_ALIGNV, PG8_SP2V, true>(lds, g, S, E); }
    GRID_BAR();
    {
        float lam;
        { const float a = wave_sum(KARG(12)[lane] * KARG(13)[lane]), b = wave_sum(KARG(14)[lane] * KARG(15)[lane]); lam = __expf(a) - __expf(b) + 0.2f; }
        LAS char* alds = (LAS char*)lds;
        for (int it = bid; it < 256 * REP_P5; it += G) {
            const int h = it & 15, y = (it >> 4) & 15;
#if !defined(ATT_TEST) || ATT_TEST == 1
            for (int s = 0; s < 2; ++s) { const int qt = s ? y : 31 - y, q0 = 256 * qt, nt = 4 * (qt + 1);
                int tl = threadIdx.x; asm volatile("" : "+v"(tl)); const int r32 = tl & 31, hi = (tl >> 5) & 1;
                att::f32x16 o[4];
                att::attn_core<att::M_SOFT_B>(PROJ + ((size_t)(0 * 16 + h) * S_ + q0) * 128, 128, PROJ + ((size_t)(1 * 16 + h) * S_) * 128, PROJ + ((size_t)(2 * 16 + h) * S_) * 128, 128, q0, nt, alds, o, 0);
                int tsp = threadIdx.x; asm volatile("" : "+v"(tsp));
                f32x4* sp = (f32x4*)(SCR + (size_t)bid * (64 * 512) + tsp * 64);
#pragma unroll
                for (int d = 0; d < 4; ++d)
#pragma unroll
                    for (int k = 0; k < 4; ++k) sp[d * 4 + k] = (f32x4){o[d][4 * k], o[d][4 * k + 1], o[d][4 * k + 2], o[d][4 * k + 3]};
                att::attn_core<att::M_SOFT_A>(PROJ + ((size_t)(0 * 16 + h) * S_ + q0) * 128, 128, PROJ + ((size_t)(1 * 16 + h) * S_) * 128, PROJ + ((size_t)(2 * 16 + h) * S_) * 128, 128, q0, nt, alds, o, 0);
#pragma unroll
                for (int d = 0; d < 4; ++d)
#pragma unroll
                    for (int k = 0; k < 4; ++k) { const f32x4 v = sp[d * 4 + k];
#pragma unroll
                        for (int e = 0; e < 4; ++e) o[d][4 * k + e] -= lam * v[e]; }
                att::store_rows<true>(o, KARG(16), 0.8f, MERGED + ((size_t)(2 * h) * S_ + q0 + wave * 32) * 64, 64, (size_t)S_ * 64, alds);
            }
#endif
#if !defined(ATT_TEST) || ATT_TEST == 2
            for (int s = 0; s < 2; ++s) { const int qt = s ? y : 31 - y, q0 = 256 * qt, nt = 4 * (qt + 1);
                int tl = threadIdx.x; asm volatile("" : "+v"(tl)); const int r32 = tl & 31, hi = (tl >> 5) & 1;
                att::f32x16 o[4];
                att::attn_core<att::M_SB>(PROJ + ((size_t)(3 * 16 + h) * S_ + q0) * 128, 128, PROJ + ((size_t)(4 * 16 + h) * S_) * 128, PROJ + ((size_t)(5 * 16 + h) * S_) * 128, 128, q0, nt, alds, o, s);
                att::store_rows<true>(o, KARG(17), 1.0f, MERGED + ((size_t)(32 + 2 * h) * S_ + q0 + wave * 32) * 64, 64, (size_t)S_ * 64, alds);
            }
#endif
        }
    }
    CONV_DRAIN(CE_WOUT);
    GRID_BAR();
#pragma unroll 1
    for (int rep = 0; rep < REP_P6; ++rep)
    { pg8::Gemm g{MERGED, WOUT, S_, D_, D_}; pg8::StaticOrder S; S.init(S_, D_, G, bid); pg8::EpiBf16SS E{Y, D_, SSP, 1.0f};
      pg8::gemm_phase<pg8::EpiBf16SS, pg8::StaticOrder, PG8_ALIGNV, PG8_SP2V, true>(lds, g, S, E); }
    GRID_BAR();
    for (int m = gw; m < S_; m += NGW) norm_row2<false, false>(XN + (size_t)m * 64, (size_t)S_ * 64, Y + (size_t)m * D_, SSP + (size_t)m * 64, 1.0f, KARG(9), nullptr, nullptr, nullptr, 0, RSTD + m, lane);
    if (STOP_AFTER <= 7) return;
    CONV_DRAIN(CE_WQ);
    GRID_BAR();
    if (bid < (S_ / 256) * (XW / 256)) {
      { pg8::Gemm g{XN, WQ, S_, XW, D_}; pg8::StaticOrder S; S.init(S_, XW, G, bid); pg8::EpiBf16S E{XQ, XW, 0.08838834764831845f * pg8::LOG2E, RSTD};
        pg8::gemm_phase<pg8::EpiBf16S, pg8::StaticOrder, false, true, true>(lds, g, S, E); }
      CONV_RAISE(2);
    } else CONV_HELP(2);
    GRID_BAR();
    if (bid < 128) {
        const int r32 = lane & 31, hi = lane >> 5; LAS char* alds = (LAS char*)lds;
        for (int it = bid; it < 128; it += G) { const int h = it & 3, q0 = 256 * (it >> 2);
            att::f32x16 o[4];
            att::attn_core<att::M_DENSE>(XQ + (size_t)q0 * XW + h * 128, XW, KV + h * 128, KV + XW + h * 128, 2 * XW, 0, 4, alds, o, 0);
            att::store_rows<false>(o, nullptr, 1.0f, XO + ((size_t)(2 * h) * S_ + q0 + wave * 32) * 64, 64, (size_t)S_ * 64, alds); }
        if (bid + G >= 128) CONV_RAISE(3);
    } else CONV_HELP(3);
    CONV_DRAIN(CE_WO);
    GRID_BAR();
    { pg8::Gemm g{XO, WO, S_, D_, XW}; pg8::StaticOrder S; S.init(S_, D_, G, bid); pg8::EpiBf16SS E{Y, D_, SSP, 1.0f};
      pg8::gemm_phase<pg8::EpiBf16SS, pg8::StaticOrder, PG8_ALIGNV, PG8_SP2V, true>(lds, g, S, E); }
    GRID_BAR();
    for (int m = gw; m < S_; m += NGW) norm_row2<false, true>(XN + (size_t)m * 64, (size_t)S_ * 64, Y + (size_t)m * D_, SSP + (size_t)m * 64, 1.0f, KARG(19), nullptr, KARG(24), XN8 + (size_t)m * 128, (size_t)S_ * 128, nullptr, lane);
    if (STOP_AFTER <= 11) return;
    CONV_DRAIN(CE_WGU2);
    GRID_BAR();
    { pg8::Gemm g{(const bf16*)XN8, WGU2, S_, 2 * FF_, D_}; pg8::StaticOrder S; S.init(S_, 2 * FF_, G, bid); pg8::EpiSwiGLU E{HID, FF_, S_, 0.00390625f, CONV_FP8 >= 2, nullptr};
      pg8::gemm_phase<pg8::EpiSwiGLU, pg8::StaticOrder, PG8_ALIGNV, PG8_SP2V, true, CONV_FP8 != 0>(lds, g, S, E); }
    CONV_DRAIN(CE_ALL);
    GRID_BAR();
    { pg8::Gemm g{HID, WD2, S_, D_, FF_}; pg8::StaticOrder S; S.init(S_, D_, G, bid); pg8::EpiBf16SS E{Y, D_, SSP, CONV_FP8 >= 2 ? 0.00390625f : 1.0f};
      pg8::gemm_phase<pg8::EpiBf16SS, pg8::StaticOrder, PG8_ALIGNV, PG8_SP2V, true, (CONV_FP8 >= 2)>(lds, g, S, E); }
    GRID_BAR();
    for (int m = gw; m < S_; m += NGW) norm_row2<true, false>(XN + (size_t)m * 64, (size_t)S_ * 64, Y + (size_t)m * D_, SSP + (size_t)m * 64, 0.5f, KARG(25), out + (size_t)m * D_, nullptr, nullptr, 0, nullptr, lane);
}

extern "C" void kernel_launch(void* const* d_in, const int* in_sizes, int n_in, void* d_out, int out_size, void* d_ws, size_t ws_size, hipStream_t stream) {
    static int grid = 0;
    if (grid == 0) {
        if (n_in != 29 || in_sizes[0] != S_ * D_ || out_size != S_ * D_ || ws_size < WS_END) {
            fprintf(stderr, "kernel_launch: built for 29 inputs, x/out of %d floats, >= %zu bytes of workspace; got n_in %d, in0 %d, out %d, ws %zu; nothing launched\n", S_ * D_, (size_t)WS_END, n_in, n_in > 0 ? in_sizes[0] : -1, out_size, ws_size); grid = -1; return; }
        int dev = 0, cus = 0, per_cu = 0;
        if (hipGetDevice(&dev) != hipSuccess || hipDeviceGetAttribute(&cus, hipDeviceAttributeMultiprocessorCount, dev) != hipSuccess) { fprintf(stderr, "kernel_launch: device query failed\n"); grid = -1; return; }
        if (hipFuncSetAttribute((const void*)mega_fwd, hipFuncAttributeMaxDynamicSharedMemorySize, LDS_BYTES) != hipSuccess) { fprintf(stderr, "kernel_launch: hipFuncSetAttribute failed\n"); grid = -1; return; }
        if (hipOccupancyMaxActiveBlocksPerMultiprocessor(&per_cu, (const void*)mega_fwd, NWAVES * 64, LDS_BYTES) != hipSuccess || per_cu < 1) {
            fprintf(stderr, "kernel_launch: occupancy query reports %d workgroups per CU; nothing launched\n", per_cu); (void)hipGetLastError(); grid = -1; return; }
        grid = cus;
        fprintf(stderr, "kernel_launch: grid %d x %d threads, %d B LDS, occupancy query %d per CU, ws %zu\n", grid, NWAVES * 64, LDS_BYTES, per_cu, ws_size);
    }
    if (grid < 0) return;
    if (hipMemsetAsync((char*)d_ws + WS_CTL, 0, CTL_ZERO_BYTES, stream) != hipSuccess) { fprintf(stderr, "kernel_launch: hipMemsetAsync failed\n"); return; }
    Args a{};
    for (int i = 0; i < 29; ++i) a.in[i] = (const float*)d_in[i];
    a.pos = (const int*)d_in[2]; a.out = (float*)d_out; a.ws = (unsigned char*)d_ws;
    for (int i = 0; i < 8; ++i) a.inv_freq[i] = (float)pow(500000.0, -(double)(2 * i) / 16.0);
    hipLaunchKernelGGL(mega_fwd, dim3(grid), dim3(NWAVES * 64), LDS_BYTES, stream, a);
    const hipError_t le = hipPeekAtLastError();
    if (le != hipSuccess) fprintf(stderr, "kernel_launch: launch failed: %s\n", hipGetErrorName(le));
}
```

```cpp
#define ATT_VPRE 1
#include <hip/hip_runtime.h>
#include <cstdio>
#include <cstdint>
#include <cmath>
#ifndef PG8_WGM
#define PG8_WGM 8
#endif
namespace pg8 {
#define PG8_LAS __attribute__((address_space(3)))
typedef unsigned short bf16_t;
typedef short bf16x8 __attribute__((ext_vector_type(8)));
typedef float f32x4 __attribute__((ext_vector_type(4)));
typedef unsigned u32x4 __attribute__((ext_vector_type(4)));
constexpr int BM = 256, BK = 64, HALF = 128, HTB = HALF * BK * 2  , STAGE_BYTES = 8 * HTB, NXCD = 8, WGM = PG8_WGM;

__host__ __device__ __forceinline__ int lds_byte(int r, int c) { const int st = (r >> 4) * 2 + (c >> 5), rr = r & 15, cc = c & 31, ob = rr * 64 + cc * 2; return st * 1024 + (ob ^ (((ob >> 9) & 1) << 5)); }
__host__ __device__ __forceinline__ void stage_rc(int b, int& R, int& C) { const int st = b / 1024, sb = b % 1024, swz = sb ^ (((sb >> 9) & 1) << 5); R = (st >> 1) * 16 + swz / 64; C = (st & 1) * 32 + (swz % 64) / 2; }
__host__ __device__ __forceinline__ int perm32(int rho) { const int n = rho >> 4, i = rho & 15; return 8 * (i >> 2) + 4 * n + (i & 3); }

struct Unit { int pm, pn; };
struct Gemm { const bf16_t* A; const bf16_t* Bt; int M, N, K; };

struct StaticOrder {
    int nM, nN, nwg, G, c;
    __host__ __device__ void init(int M, int N, int G_, int c_) { nM = M / BM; nN = N / BM; nwg = nM * nN; G = G_; c = c_; }
    __host__ __device__ bool next(int i, Unit& u) const {
        const long L = (long)i * G + c; if (L >= nwg) return false;
        int wgid = (int)L; { const int q = nwg / NXCD, r = nwg % NXCD, xcd = wgid % NXCD, off = wgid / NXCD; wgid = (xcd < r ? xcd * (q + 1) : r * (q + 1) + (xcd - r) * q) + off; }
        const int nig = WGM * nN, gid = wgid / nig, fm = gid * WGM, gsz = (nM - fm) < WGM ? (nM - fm) : WGM;
        u.pm = fm + ((wgid % nig) % gsz); u.pn = (wgid % nig) / gsz; return true;
    }
    __device__ __forceinline__ void a_ready(const Unit&) const {}
    __device__ __forceinline__ void done(const Unit&) const {}
};
__device__ __forceinline__ unsigned cvt_pk_bf16(float lo, float hi) { unsigned r; asm volatile("v_cvt_pk_bf16_f32 %0, %1, %2" : "=v"(r) : "v"(lo), "v"(hi)); return r; }

constexpr float LOG2E = 1.4426950408889634f;

struct EpiF32 {
    static constexpr bool PERM = false, AFTER_DRAIN = false;
    float* C; int ldc;
    __device__ __forceinline__ void operator()(const f32x4 (&acc)[2][2][4][2], const Unit& u, int wr, int wc, int fr, int fq) const {
        const int row0 = u.pm * BM + wr * 64 + fr, col0 = u.pn * BM + wc * 32 + 4 * fq;
#pragma unroll
        for (int ai = 0; ai < 2; ++ai)
#pragma unroll
            for (int m = 0; m < 4; ++m) { float* rowp = C + (size_t)(row0 + ai * HALF + m * 16) * ldc + col0;
#pragma unroll
                for (int bj = 0; bj < 2; ++bj)
#pragma unroll
                    for (int n = 0; n < 2; ++n) *(f32x4*)(rowp + bj * HALF + n * 16) = acc[ai][bj][m][n]; }
    }
};
struct EpiBf16S {
    static constexpr bool PERM = true, AFTER_DRAIN = false;
    bf16_t* O; int ldc; float sc; const float* rs;
    __device__ __forceinline__ void operator()(const f32x4 (&acc)[2][2][4][2], const Unit& u, int wr, int wc, int fr, int fq) const {
        const int row0 = u.pm * BM + wr * 64 + fr, col0 = u.pn * BM + wc * 32 + 8 * fq;
#pragma unroll
        for (int ai = 0; ai < 2; ++ai)
#pragma unroll
            for (int m = 0; m < 4; ++m) { bf16_t* rowp = O + (size_t)(row0 + ai * HALF + m * 16) * ldc + col0;
                const float scr = rs ? sc * rs[row0 + ai * HALF + m * 16] : sc;
#pragma unroll
                for (int bj = 0; bj < 2; ++bj) { const f32x4 v0 = acc[ai][bj][m][0] * scr, v1 = acc[ai][bj][m][1] * scr;
                    u32x4 w; w.x = cvt_pk_bf16(v0[0], v0[1]); w.y = cvt_pk_bf16(v0[2], v0[3]); w.z = cvt_pk_bf16(v1[0], v1[1]); w.w = cvt_pk_bf16(v1[2], v1[3]);
                    *(u32x4*)(rowp + bj * HALF) = w; } }
    }
};
struct EpiBf16SS {
    static constexpr bool PERM = true, AFTER_DRAIN = false;
    bf16_t* O; int ldc; float* SSP; float sc;
    __device__ __forceinline__ void operator()(const f32x4 (&acc)[2][2][4][2], const Unit& u, int wr, int wc, int fr, int fq) const {
        const int row0 = u.pm * BM + wr * 64 + fr, col0 = u.pn * BM + wc * 32 + 8 * fq;
#pragma unroll
        for (int ai = 0; ai < 2; ++ai)
#pragma unroll
            for (int m = 0; m < 4; ++m) { const int row = row0 + ai * HALF + m * 16; bf16_t* rowp = O + (size_t)row * ldc + col0; float ss = 0.f;
#pragma unroll
                for (int bj = 0; bj < 2; ++bj) { const f32x4 v0 = acc[ai][bj][m][0] * sc, v1 = acc[ai][bj][m][1] * sc;
                    ss += ((v0[0] * v0[0] + v0[1] * v0[1]) + (v0[2] * v0[2] + v0[3] * v0[3])) + ((v1[0] * v1[0] + v1[1] * v1[1]) + (v1[2] * v1[2] + v1[3] * v1[3]));
                    u32x4 w; w.x = cvt_pk_bf16(v0[0], v0[1]); w.y = cvt_pk_bf16(v0[2], v0[3]); w.z = cvt_pk_bf16(v1[0], v1[1]); w.w = cvt_pk_bf16(v1[2], v1[3]);
                    *(u32x4*)(rowp + bj * HALF) = w; }
                ss += __shfl_xor(ss, 16); ss += __shfl_xor(ss, 32);
                if (fq == 0) SSP[(size_t)row * 64 + u.pn * 4 + wc] = ss; }
    }
};
__device__ __forceinline__ float silu_mul(float g, float u) { const float s = __builtin_amdgcn_exp2f(-g * LOG2E); return g * __builtin_amdgcn_rcpf(1.0f + s) * u; }
struct EpiSwiGLU {
    static constexpr bool PERM = true, AFTER_DRAIN = false;
    bf16_t* O; int ldc; int blkM; float sc; int fp8out; const float* rs;
    __device__ __forceinline__ void operator()(const f32x4 (&acc)[2][2][4][2], const Unit& u, int wr, int wc, int fr, int fq) const {
        const int row0 = u.pm * BM + wr * 64 + fr, col0 = u.pn * HALF + wc * 32 + 8 * fq;
        const size_t rpitch = blkM ? (size_t)BK : (size_t)ldc, cbase = blkM ? (size_t)(col0 >> 6) * blkM * BK + (col0 & 63) : (size_t)col0;
#pragma unroll
        for (int ai = 0; ai < 2; ++ai)
#pragma unroll
            for (int m = 0; m < 4; ++m) { bf16_t* rowp = O + (size_t)(row0 + ai * HALF + m * 16) * rpitch + cbase;
                const float scr = rs ? sc * rs[row0 + ai * HALF + m * 16] : sc;
                const f32x4 g0 = acc[ai][0][m][0] * scr, g1 = acc[ai][0][m][1] * scr, u0 = acc[ai][1][m][0] * scr, u1 = acc[ai][1][m][1] * scr;
                if (fp8out) { typedef unsigned u32x2_ __attribute__((ext_vector_type(2))); u32x2_ w8;
                    int t0 = __builtin_amdgcn_cvt_pk_fp8_f32(silu_mul(g0[0], u0[0]), silu_mul(g0[1], u0[1]), 0, false); t0 = __builtin_amdgcn_cvt_pk_fp8_f32(silu_mul(g0[2], u0[2]), silu_mul(g0[3], u0[3]), t0, true);
                    int t1 = __builtin_amdgcn_cvt_pk_fp8_f32(silu_mul(g1[0], u1[0]), silu_mul(g1[1], u1[1]), 0, false); t1 = __builtin_amdgcn_cvt_pk_fp8_f32(silu_mul(g1[2], u1[2]), silu_mul(g1[3], u1[3]), t1, true);
                    w8.x = (unsigned)t0; w8.y = (unsigned)t1;
                    *(u32x2_*)((unsigned char*)O + ((size_t)u.pn * blkM + (row0 + ai * HALF + m * 16)) * 128 + wc * 32 + 8 * fq) = w8; }
                else {
                u32x4 w; w.x = cvt_pk_bf16(silu_mul(g0[0], u0[0]), silu_mul(g0[1], u0[1])); w.y = cvt_pk_bf16(silu_mul(g0[2], u0[2]), silu_mul(g0[3], u0[3]));
                w.z = cvt_pk_bf16(silu_mul(g1[0], u1[0]), silu_mul(g1[1], u1[1])); w.w = cvt_pk_bf16(silu_mul(g1[2], u1[2]), silu_mul(g1[3], u1[3]));
                *(u32x4*)rowp = w; } }
    }
};
struct EpiProj {
    static constexpr bool PERM = true, AFTER_DRAIN = false;
    bf16_t* O; int ldc; const float* rope; const float* rs;
    __device__ __forceinline__ void operator()(const f32x4 (&acc)[2][2][4][2], const Unit& u, int wr, int wc, int fr, int fq) const {
        const int region = u.pn >> 3;
        const float sc = region == 0 ? 0.125f * LOG2E : (region == 3 ? 0.08838834764831845f * LOG2E : 1.0f);
        const bool rope_wave = (region < 2) && ((wc & 1) == 0);
        const int row0 = u.pm * BM + wr * 64 + fr;
        const float sgn = fq == 0 ? -1.0f : 1.0f;
        bf16_t* hp = O + ((size_t)(region * 16 + (u.pn & 7) * 2) * ldc) * 128 + wc * 32 + 8 * fq;
#pragma unroll
        for (int ai = 0; ai < 2; ++ai)
#pragma unroll
            for (int m = 0; m < 4; ++m) { const int row = row0 + ai * HALF + m * 16; bf16_t* rowp = hp + (size_t)row * 128;
                const float scr = sc * rs[row];
                f32x4 c0 = {1.f, 1.f, 1.f, 1.f}, c1 = c0, s0 = {0.f, 0.f, 0.f, 0.f}, s1 = s0;
                if (rope_wave && fq < 2) { const f32x4* rp = (const f32x4*)(rope + (size_t)row * 16); c0 = rp[0]; c1 = rp[1]; s0 = rp[2] * sgn; s1 = rp[3] * sgn; }
#pragma unroll
                for (int bj = 0; bj < 2; ++bj) { f32x4 v0 = acc[ai][bj][m][0], v1 = acc[ai][bj][m][1];
                    if (rope_wave) { f32x4 o0, o1;
#pragma unroll
                        for (int j = 0; j < 4; ++j) { o0[j] = __shfl_xor(v0[j], 16); o1[j] = __shfl_xor(v1[j], 16); }
                        v0 = v0 * c0 + o0 * s0; v1 = v1 * c1 + o1 * s1; }
                    v0 = v0 * scr; v1 = v1 * scr;
                    u32x4 w; w.x = cvt_pk_bf16(v0[0], v0[1]); w.y = cvt_pk_bf16(v0[2], v0[3]); w.z = cvt_pk_bf16(v1[0], v1[1]); w.w = cvt_pk_bf16(v1[2], v1[3]);
                    *(u32x4*)(rowp + (size_t)bj * ldc * 128) = w; }
                asm volatile("" ::: "memory"); }
    }
};
struct RowOrder {
    int nN, G, c;
    __device__ bool next(int i, Unit& u) const { const int L = i * G + c; if (L >= nN) return false; u.pm = 0; u.pn = L; return true; }
    __device__ __forceinline__ void a_ready(const Unit&) const {}
    __device__ __forceinline__ void done(const Unit&) const {}
};
template <class Epi, class Sched, bool ALIGN_EPI = false, bool SP2 = false, bool BLK = false, bool FP8 = false>
__device__ __forceinline__ void gemm_phase(PG8_LAS unsigned char* lds, const Gemm g, const Sched& S, const Epi& E) {
    int tid_ = threadIdx.x; asm volatile("" : "+v"(tid_));
    const int tid = tid_, wid = __builtin_amdgcn_readfirstlane(tid >> 6), lane = tid & 63, wr = wid >> 2, wc = wid & 3, fr = lane & 15, fq = lane >> 4;
    const int K = g.K, nt = K / (FP8 ? 2 * BK : BK);
    const int pitch = BLK ? BK : K;
    unsigned voffA[2], voffB[2];
#pragma unroll
    for (int i = 0; i < 2; ++i) { int R, C; stage_rc(tid * 16 + i * 8192, R, C); const int Rb = Epi::PERM ? ((R & ~31) + perm32(R & 31)) : R;
        voffA[i] = (unsigned)(R * pitch + C) * 2u; voffB[i] = (unsigned)(Rb * pitch + C) * 2u; }
    const size_t kstepA = BLK ? (size_t)g.M * BK * 2 : (size_t)(BK * 2), kstepB = BLK ? (size_t)g.N * BK * 2 : (size_t)(BK * 2);
    const size_t hstep = (size_t)HALF * pitch * 2;
    const size_t tstep = 2 * hstep;
    const unsigned ldsw = (unsigned)wid * 1024u;
    const int aoff = lds_byte(wr * 64 + fr, fq * 8), boff = lds_byte(wc * 32 + fr, fq * 8);
#define PG8_SA(b, h) (((b) * 2 + (h)) * HTB)
#define PG8_SB(b, h) ((4 + (b) * 2 + (h)) * HTB)
#define PG8_STAGE(bufoff, gbase, voff) do { _Pragma("unroll") for (int _i = 0; _i < 2; ++_i) \
        __builtin_amdgcn_global_load_lds((const unsigned*)((const char*)(gbase) + (voff)[_i]), (PG8_LAS unsigned*)(lds + (bufoff) + ldsw + _i * 8192), 16, 0, 0); } while (0)
#define PG8_LDA(dst, b, h) do { if constexpr (FP8) { _Pragma("unroll") for (int m = 0; m < 4; ++m) { const i32x4_ lo_ = *(const PG8_LAS i32x4_*)(lds + PG8_SA(b, h) + aoff + m * 2048), hi_ = *(const PG8_LAS i32x4_*)(lds + PG8_SA(b, h) + aoff + m * 2048 + 1024); \
            dst##8[m] = __builtin_shufflevector(lo_, hi_, 0, 1, 2, 3, 4, 5, 6, 7); } } \
        else { _Pragma("unroll") for (int m = 0; m < 4; ++m) _Pragma("unroll") for (int k = 0; k < 2; ++k) dst[m][k] = *(const PG8_LAS bf16x8*)(lds + PG8_SA(b, h) + aoff + m * 2048 + k * 1024); } } while (0)
#define PG8_LDB(dst, b, h) do { if constexpr (FP8) { _Pragma("unroll") for (int n = 0; n < 2; ++n) { const i32x4_ lo_ = *(const PG8_LAS i32x4_*)(lds + PG8_SB(b, h) + boff + n * 2048), hi_ = *(const PG8_LAS i32x4_*)(lds + PG8_SB(b, h) + boff + n * 2048 + 1024); \
            dst##8[n] = __builtin_shufflevector(lo_, hi_, 0, 1, 2, 3, 4, 5, 6, 7); } } \
        else { _Pragma("unroll") for (int n = 0; n < 2; ++n) _Pragma("unroll") for (int k = 0; k < 2; ++k) dst[n][k] = *(const PG8_LAS bf16x8*)(lds + PG8_SB(b, h) + boff + n * 2048 + k * 1024); } } while (0)
#define PG8_MMA(ai, bj, At, Bt) do { __builtin_amdgcn_s_setprio(1); _Pragma("unroll") for (int m = 0; m < 4; ++m) _Pragma("unroll") for (int n = 0; n < 2; ++n) { \
        if constexpr (FP8) asm volatile("v_mfma_scale_f32_16x16x128_f8f6f4 %0, %1, %2, %0, %3, %3 op_sel_hi:[0,0,0]" : "+v"(acc[ai][bj][m][n]) : "v"(Bt##8[n]), "v"(At##8[m]), "v"(0x7f7f7f7f)); \
        else { _Pragma("unroll") for (int k = 0; k < 2; ++k) acc[ai][bj][m][n] = __builtin_amdgcn_mfma_f32_16x16x32_bf16(Bt[n][k], At[m][k], acc[ai][bj][m][n], 0, 0, 0); } } \
        __builtin_amdgcn_s_setprio(0); } while (0)
#define PG8_WAIT_V(n) asm volatile("s_waitcnt vmcnt(" #n ")" ::: "memory")
#define PG8_WAIT_L(n) asm volatile("s_waitcnt lgkmcnt(" #n ")" ::: "memory")
#define PG8_BAR __builtin_amdgcn_s_barrier()
#define PG8_SCHED __builtin_amdgcn_sched_barrier(0)
    Unit cur, nxt; int ui = 0;
    if (!S.next(0, cur)) return;
    f32x4 acc[2][2][4][2];
#pragma unroll
    for (int a = 0; a < 2; ++a)
#pragma unroll
        for (int b = 0; b < 2; ++b)
#pragma unroll
            for (int m = 0; m < 4; ++m)
#pragma unroll
                for (int n = 0; n < 2; ++n) acc[a][b][m][n] = (f32x4){0.f, 0.f, 0.f, 0.f};
    typedef int i32x4_ __attribute__((ext_vector_type(4))); typedef int i32x8_ __attribute__((ext_vector_type(8)));
    bf16x8 At[4][2], B0[2][2], B1[2][2]; i32x8_ At8[4], B08[2], B18[2];
    const char* cA = (const char*)g.A + (size_t)cur.pm * tstep; const char* cB = (const char*)g.Bt + (size_t)cur.pn * tstep;
    S.a_ready(cur);
    if constexpr (SP2) {
        PG8_STAGE(PG8_SB(0, 0), cB, voffB); PG8_STAGE(PG8_SB(0, 1), cB + hstep, voffB); PG8_STAGE(PG8_SA(0, 0), cA, voffA); PG8_STAGE(PG8_SA(0, 1), cA + hstep, voffA);
        if (wr == 1) PG8_BAR;
        PG8_WAIT_V(2); PG8_BAR;
        PG8_STAGE(PG8_SB(1, 0), cB + kstepB, voffB); PG8_STAGE(PG8_SA(1, 0), cA + kstepA, voffA); PG8_STAGE(PG8_SB(1, 1), cB + hstep + kstepB, voffB);
        PG8_WAIT_V(6); PG8_BAR;
    } else {
        PG8_STAGE(PG8_SB(0, 0), cB, voffB); PG8_STAGE(PG8_SA(0, 0), cA, voffA); PG8_STAGE(PG8_SB(0, 1), cB + hstep, voffB); PG8_STAGE(PG8_SA(0, 1), cA + hstep, voffA);
        if (wr == 1) PG8_BAR;
        PG8_WAIT_V(4); PG8_BAR;
        PG8_STAGE(PG8_SB(1, 0), cB + kstepB, voffB); PG8_STAGE(PG8_SA(1, 0), cA + kstepA, voffA); PG8_STAGE(PG8_SB(1, 1), cB + hstep + kstepB, voffB);
        PG8_WAIT_V(6); PG8_BAR;
    }
    for (;;) {
        const bool has_next = S.next(ui + 1, nxt);
        const char* nA = has_next ? (const char*)g.A + (size_t)nxt.pm * tstep : cA; const char* nB = has_next ? (const char*)g.Bt + (size_t)nxt.pn * tstep : cB;
        for (int t = 0; t < nt; t += 2) {
            const bool last = (t == nt - 2);
            const char* a1 = cA + (size_t)(t + 1) * kstepA;
            const char* a2 = last ? nA : cA + (size_t)(t + 2) * kstepA; const char* b2 = last ? nB : cB + (size_t)(t + 2) * kstepB;
            const char* a3 = a2 + kstepA; const char* b3 = b2 + kstepB;
            if (last && has_next) S.a_ready(nxt);
            if constexpr (SP2) {
            PG8_LDB(B0, 0, 0); PG8_LDB(B1, 0, 1); PG8_SCHED; PG8_LDA(At, 0, 0); PG8_STAGE(PG8_SA(1, 1), a1 + hstep, voffA);
            PG8_WAIT_V(8); PG8_WAIT_L(0); PG8_BAR; PG8_MMA(0, 0, At, B0); PG8_MMA(0, 1, At, B1); PG8_BAR; PG8_SCHED;
            PG8_LDA(At, 0, 1); PG8_STAGE(PG8_SB(0, 0), b2, voffB); PG8_STAGE(PG8_SB(0, 1), b2 + hstep, voffB); PG8_STAGE(PG8_SA(0, 0), a2, voffA);
            PG8_WAIT_V(8); PG8_WAIT_L(0); PG8_BAR; PG8_MMA(1, 0, At, B0); PG8_MMA(1, 1, At, B1); PG8_BAR; PG8_SCHED;
            PG8_LDB(B0, 1, 0); PG8_LDB(B1, 1, 1); PG8_SCHED; PG8_LDA(At, 1, 0); PG8_STAGE(PG8_SA(0, 1), a2 + hstep, voffA);
            PG8_WAIT_V(8); PG8_WAIT_L(0); PG8_BAR; PG8_MMA(0, 0, At, B0); PG8_MMA(0, 1, At, B1); PG8_BAR; PG8_SCHED;
            PG8_LDA(At, 1, 1); PG8_STAGE(PG8_SB(1, 0), b3, voffB); PG8_STAGE(PG8_SB(1, 1), b3 + hstep, voffB); PG8_STAGE(PG8_SA(1, 0), a3, voffA);
            PG8_WAIT_V(8); PG8_WAIT_L(0); PG8_BAR; PG8_MMA(1, 0, At, B0); PG8_MMA(1, 1, At, B1); PG8_BAR; PG8_SCHED;
            } else {
            PG8_LDB(B0, 0, 0); PG8_SCHED; PG8_LDA(At, 0, 0); PG8_STAGE(PG8_SA(1, 1), a1 + hstep, voffA);
            PG8_WAIT_L(8); PG8_BAR; PG8_WAIT_L(0); PG8_MMA(0, 0, At, B0); PG8_BAR; PG8_SCHED;
            PG8_LDB(B1, 0, 1); PG8_STAGE(PG8_SB(0, 0), b2, voffB);
            PG8_BAR; PG8_WAIT_L(0); PG8_MMA(0, 1, At, B1); PG8_BAR;
            PG8_LDA(At, 0, 1); PG8_STAGE(PG8_SA(0, 0), a2, voffA);
            PG8_BAR; PG8_WAIT_L(0); PG8_MMA(1, 0, At, B0); PG8_BAR; PG8_SCHED;
            PG8_STAGE(PG8_SB(0, 1), b2 + hstep, voffB);
            PG8_WAIT_V(6); PG8_BAR; PG8_MMA(1, 1, At, B1); PG8_BAR;
            PG8_LDB(B0, 1, 0); PG8_SCHED; PG8_LDA(At, 1, 0); PG8_STAGE(PG8_SA(0, 1), a2 + hstep, voffA);
            PG8_WAIT_L(8); PG8_BAR; PG8_WAIT_L(0); PG8_MMA(0, 0, At, B0); PG8_BAR; PG8_SCHED;
            PG8_LDB(B1, 1, 1); PG8_STAGE(PG8_SB(1, 0), b3, voffB);
            PG8_BAR; PG8_WAIT_L(0); PG8_MMA(0, 1, At, B1); PG8_BAR;
            PG8_LDA(At, 1, 1); PG8_STAGE(PG8_SA(1, 0), a3, voffA);
            PG8_BAR; PG8_WAIT_L(0); PG8_MMA(1, 0, At, B0); PG8_BAR; PG8_SCHED;
            PG8_STAGE(PG8_SB(1, 1), b3 + hstep, voffB);
            PG8_WAIT_V(6); PG8_BAR; PG8_MMA(1, 1, At, B1); PG8_BAR;
            }
        }
        if constexpr (ALIGN_EPI) { if (wr == 0) PG8_BAR; }
        if constexpr (FP8) asm volatile("s_nop 15\n\ts_nop 15" ::: "memory");
        if constexpr (!Epi::AFTER_DRAIN) { int tz = tid; asm volatile("" : "+v"(tz));
            E(acc, cur, wr, wc, tz & 15, (tz & 63) >> 4); S.done(cur); }
        if (!has_next) break;
#pragma unroll
        for (int a = 0; a < 2; ++a)
#pragma unroll
            for (int b = 0; b < 2; ++b)
#pragma unroll
                for (int m = 0; m < 4; ++m)
#pragma unroll
                    for (int n = 0; n < 2; ++n) acc[a][b][m][n] = (f32x4){0.f, 0.f, 0.f, 0.f};
        cur = nxt; cA = nA; cB = nB; ++ui;
        if constexpr (ALIGN_EPI) { if (wr == 1) PG8_BAR; }
    }
    PG8_WAIT_V(0);
    if constexpr (!ALIGN_EPI) { if (wr == 0) PG8_BAR; }
    PG8_BAR;
    if constexpr (Epi::AFTER_DRAIN) { E.fused(acc, cur, wr, wc, fr, fq, lds, wid, lane); S.done(cur); }
#undef PG8_SA
#undef PG8_SB
#undef PG8_STAGE
#undef PG8_LDA
#undef PG8_LDB
#undef PG8_MMA
#undef PG8_WAIT_V
#undef PG8_WAIT_L
#undef PG8_BAR
#undef PG8_SCHED
}
}

namespace att {
#define ATT_LAS __attribute__((address_space(3)))
typedef unsigned short bf16_t;
typedef short bf16x8 __attribute__((ext_vector_type(8)));
typedef short s16x4 __attribute__((ext_vector_type(4)));
typedef float f32x16 __attribute__((ext_vector_type(16)));
typedef float f32x4 __attribute__((ext_vector_type(4)));
typedef unsigned u32x4 __attribute__((ext_vector_type(4)));
constexpr int SHM_K = 64 * 128 * 2, SHM_V = 64 * 128 * 2;
constexpr int NBUF = 4, SCR_OFF = 131072 + 1024;
constexpr int LDS_BYTES = SCR_OFF + 8 * 64 * 4 + 64;
constexpr float SB_EPS = 9.094947017729282e-13f;
#define ATT_KSWZ(row, colB) ((row) * 256 + ((colB) ^ (((row) & 7) << 4)))
#define ATT_SBAR() __builtin_amdgcn_sched_barrier(0)
__device__ __forceinline__ int crow(int r, int hi) { return (r & 3) + 8 * (r >> 2) + 4 * hi; }
__device__ __forceinline__ unsigned cvtpk(float lo, float hi) { unsigned r; asm volatile("v_cvt_pk_bf16_f32 %0, %1, %2" : "=v"(r) : "v"(lo), "v"(hi)); return r; }
__device__ __forceinline__ int v_st(int k, int c) { const int kk = (k & ~0xC) | ((k & 4) << 1) | ((k & 8) >> 1); return ((kk >> 3) * 4 + (c >> 5)) * 512 + ((kk & 7) * 32 + (c & 31)) * 2; }
__device__ __forceinline__ int v_rd_base(int lane) { return ((lane & 3) << 3) | (((lane >> 2) & 3) << 6) | (((lane >> 4) & 1) << 5) | (((lane >> 5) & 1) << 8); }
constexpr int v_rd_off(int d0, int ks, int half) { return d0 * 512 + ks * 4096 + half * 2048; }
template <int OFF> __device__ __forceinline__ s16x4 tr_read(int vb) { s16x4 r; asm volatile("ds_read_b64_tr_b16 %0, %1 offset:%2" : "=&v"(r) : "v"(vb), "i"(OFF) : "memory"); return r; }
template <int D0> __device__ __forceinline__ void pv_one(f32x16& od, int vb, bf16x8 pa0, bf16x8 pa1, bf16x8 pa2, bf16x8 pa3) {
  const s16x4 l0 = tr_read<v_rd_off(D0, 0, 0)>(vb), h0 = tr_read<v_rd_off(D0, 0, 1)>(vb), l1 = tr_read<v_rd_off(D0, 1, 0)>(vb), h1 = tr_read<v_rd_off(D0, 1, 1)>(vb);
  const s16x4 l2 = tr_read<v_rd_off(D0, 2, 0)>(vb), h2 = tr_read<v_rd_off(D0, 2, 1)>(vb), l3 = tr_read<v_rd_off(D0, 3, 0)>(vb), h3 = tr_read<v_rd_off(D0, 3, 1)>(vb);
  asm volatile("s_waitcnt lgkmcnt(0)" ::: "memory"); ATT_SBAR();
#define ATT_PK(L, H) (bf16x8){L[0], L[1], L[2], L[3], H[0], H[1], H[2], H[3]}
  od = __builtin_amdgcn_mfma_f32_32x32x16_bf16(pa0, ATT_PK(l0, h0), od, 0, 0, 0);
  od = __builtin_amdgcn_mfma_f32_32x32x16_bf16(pa1, ATT_PK(l1, h1), od, 0, 0, 0);
  od = __builtin_amdgcn_mfma_f32_32x32x16_bf16(pa2, ATT_PK(l2, h2), od, 0, 0, 0);
  od = __builtin_amdgcn_mfma_f32_32x32x16_bf16(pa3, ATT_PK(l3, h3), od, 0, 0, 0);
#undef ATT_PK
}
struct VFrag { s16x4 l0, h0, l1, h1, l2, h2, l3, h3; };
template <int D0> __device__ __forceinline__ void v_read8(VFrag& f, int vb) {
  f.l0 = tr_read<v_rd_off(D0, 0, 0)>(vb); f.h0 = tr_read<v_rd_off(D0, 0, 1)>(vb); f.l1 = tr_read<v_rd_off(D0, 1, 0)>(vb); f.h1 = tr_read<v_rd_off(D0, 1, 1)>(vb);
  f.l2 = tr_read<v_rd_off(D0, 2, 0)>(vb); f.h2 = tr_read<v_rd_off(D0, 2, 1)>(vb); f.l3 = tr_read<v_rd_off(D0, 3, 0)>(vb); f.h3 = tr_read<v_rd_off(D0, 3, 1)>(vb);
}
__device__ __forceinline__ void pv_mma(f32x16& od, const VFrag& f, bf16x8 pa0, bf16x8 pa1, bf16x8 pa2, bf16x8 pa3) {
#define ATT_PK(L, H) (bf16x8){L[0], L[1], L[2], L[3], H[0], H[1], H[2], H[3]}
  od = __builtin_amdgcn_mfma_f32_32x32x16_bf16(pa0, ATT_PK(f.l0, f.h0), od, 0, 0, 0);
  od = __builtin_amdgcn_mfma_f32_32x32x16_bf16(pa1, ATT_PK(f.l1, f.h1), od, 0, 0, 0);
  od = __builtin_amdgcn_mfma_f32_32x32x16_bf16(pa2, ATT_PK(f.l2, f.h2), od, 0, 0, 0);
  od = __builtin_amdgcn_mfma_f32_32x32x16_bf16(pa3, ATT_PK(f.l3, f.h3), od, 0, 0, 0);
#undef ATT_PK
}
__device__ __forceinline__ void pv_d0(f32x16 (&o)[4], int vb, bf16x8 pa0, bf16x8 pa1, bf16x8 pa2, bf16x8 pa3) {
  VFrag fa, fb;
  v_read8<0>(fa, vb); v_read8<1>(fb, vb);
  asm volatile("s_waitcnt lgkmcnt(8)" ::: "memory"); ATT_SBAR();
  pv_mma(o[0], fa, pa0, pa1, pa2, pa3); ATT_SBAR();
  v_read8<2>(fa, vb);
  asm volatile("s_waitcnt lgkmcnt(8)" ::: "memory"); ATT_SBAR();
  pv_mma(o[1], fb, pa0, pa1, pa2, pa3); ATT_SBAR();
  v_read8<3>(fb, vb);
  asm volatile("s_waitcnt lgkmcnt(8)" ::: "memory"); ATT_SBAR();
  pv_mma(o[2], fa, pa0, pa1, pa2, pa3); ATT_SBAR();
  asm volatile("s_waitcnt lgkmcnt(0)" ::: "memory"); ATT_SBAR();
  pv_mma(o[3], fb, pa0, pa1, pa2, pa3);
}
template <int OFF> __device__ __forceinline__ bf16x8 lds_read16(int a) { bf16x8 r; asm volatile("ds_read_b128 %0, %1 offset:%2" : "=&v"(r) : "v"(a), "i"(OFF) : "memory"); return r; }
template <int D0> __device__ __forceinline__ void qkt4(f32x16& p0, f32x16& p1, int kbase, const bf16x8 (&qr)[8], int r32, int hi) {
  bf16x8 kf[8];
#pragma unroll
  for (int i = 0; i < 4; ++i) { const int cb = ((D0 + i) * 16 + hi * 8) * 2, a = kbase + ATT_KSWZ(r32, cb); kf[2 * i] = lds_read16<0>(a); kf[2 * i + 1] = lds_read16<32 * 256>(a); }
  asm volatile("s_waitcnt lgkmcnt(4)" ::: "memory"); ATT_SBAR();
#pragma unroll
  for (int i = 0; i < 2; ++i) { p0 = __builtin_amdgcn_mfma_f32_32x32x16_bf16(kf[2 * i], qr[D0 + i], p0, 0, 0, 0); p1 = __builtin_amdgcn_mfma_f32_32x32x16_bf16(kf[2 * i + 1], qr[D0 + i], p1, 0, 0, 0); }
  ATT_SBAR(); asm volatile("s_waitcnt lgkmcnt(0)" ::: "memory"); ATT_SBAR();
#pragma unroll
  for (int i = 2; i < 4; ++i) { p0 = __builtin_amdgcn_mfma_f32_32x32x16_bf16(kf[2 * i], qr[D0 + i], p0, 0, 0, 0); p1 = __builtin_amdgcn_mfma_f32_32x32x16_bf16(kf[2 * i + 1], qr[D0 + i], p1, 0, 0, 0); }
}
template <int DLO, int DHI> __device__ __forceinline__ void qkt(f32x16& p0, f32x16& p1, const ATT_LAS char* Ks, const bf16x8 (&qr)[8], int r32, int hi) {
#pragma unroll
  for (int r = 0; r < 16; ++r) { p0[r] = 0.f; p1[r] = 0.f; }
  const int kbase = (int)(unsigned)(uintptr_t)Ks;
  qkt4<DLO>(p0, p1, kbase, qr, r32, hi);
  if (DHI - DLO == 8) qkt4<DLO + 4>(p0, p1, kbase, qr, r32, hi);
}
__device__ __forceinline__ void pack_p(const f32x16& p0, const f32x16& p1, bf16x8& pa0, bf16x8& pa1, bf16x8& pa2, bf16x8& pa3) {
#define ATT_PK4(P, BASE, OUT) do { unsigned a0 = cvtpk(P[BASE + 0], P[BASE + 1]), a1 = cvtpk(P[BASE + 2], P[BASE + 3]);   \
    unsigned b0 = cvtpk(P[BASE + 4], P[BASE + 5]), b1 = cvtpk(P[BASE + 6], P[BASE + 7]);                              \
    auto r0 = __builtin_amdgcn_permlane32_swap(a0, b0, false, false); auto r1 = __builtin_amdgcn_permlane32_swap(a1, b1, false, false); \
    u32x4 w = {r0[0], r1[0], r0[1], r1[1]}; OUT = __builtin_bit_cast(bf16x8, w); } while (0)
  ATT_PK4(p0, 0, pa0); ATT_PK4(p0, 8, pa1); ATT_PK4(p1, 0, pa2); ATT_PK4(p1, 8, pa3);
#undef ATT_PK4
}

__device__ __forceinline__ void pv_pre(VFrag& fa, VFrag& fb, int vb) { v_read8<0>(fa, vb); v_read8<1>(fb, vb); }
__device__ __forceinline__ void pv_post(f32x16 (&o)[4], VFrag& fa, VFrag& fb, int vb, bf16x8 pa0, bf16x8 pa1, bf16x8 pa2, bf16x8 pa3) {
  asm volatile("s_waitcnt lgkmcnt(0)" ::: "memory"); ATT_SBAR();
  pv_mma(o[0], fa, pa0, pa1, pa2, pa3); ATT_SBAR();
  v_read8<2>(fa, vb); ATT_SBAR();
  pv_mma(o[1], fb, pa0, pa1, pa2, pa3); ATT_SBAR();
  v_read8<3>(fb, vb);
  asm volatile("s_waitcnt lgkmcnt(8)" ::: "memory"); ATT_SBAR();
  pv_mma(o[2], fa, pa0, pa1, pa2, pa3); ATT_SBAR();
  asm volatile("s_waitcnt lgkmcnt(0)" ::: "memory"); ATT_SBAR();
  pv_mma(o[3], fb, pa0, pa1, pa2, pa3);
}

enum { M_SOFT_A = 0, M_SOFT_B = 1, M_SB = 2, M_DENSE = 3 };
template <int MODE>
__device__ __forceinline__ void attn_core(const bf16_t* __restrict__ Q0, int ldq, const bf16_t* __restrict__ Kb, const bf16_t* __restrict__ Vb, int ldk,
                                          int qpos0, int nt, ATT_LAS char* lds, f32x16 (&o)[4], int par) {
  constexpr bool SOFT = (MODE != M_SB), CAUSAL = (MODE == M_SOFT_A || MODE == M_SOFT_B), STRICT = (MODE == M_SB);
  constexpr int DLO = (MODE == M_SOFT_B) ? 4 : 0, DHI = (MODE == M_SOFT_A) ? 4 : 8;
  int tid_ = threadIdx.x; asm volatile("" : "+v"(tid_));
  const int tid = tid_, wid = __builtin_amdgcn_readfirstlane(tid >> 6), lane = tid & 63, r32 = lane & 31, hi = lane >> 5;
  ATT_LAS char* V_lds = lds; ATT_LAS char* K_lds = lds + NBUF * SHM_V;
  ATT_LAS float* wsf = (ATT_LAS float*)(lds + SCR_OFF) + wid * 64; ATT_LAS float* li_l = wsf; ATT_LAS float* al_l = wsf + 32;
#pragma unroll
  for (int d = 0; d < 4; ++d)
#pragma unroll
    for (int r = 0; r < 16; ++r) o[d][r] = 0.f;
  bf16x8 qr[8];
  { const bf16_t* Qw = Q0 + (size_t)(wid * 32 + r32) * ldq + hi * 8;
#pragma unroll
    for (int d0 = DLO; d0 < DHI; ++d0) qr[d0] = *(const bf16x8*)(Qw + d0 * 16); }
  const int ksrc = (tid >> 4) * ldk + (((tid & 15) ^ ((tid >> 4) & 7)) << 3);
  const int vkk = ((tid >> 7) << 3) | ((tid & 31) >> 2), vk = (vkk & ~0xC) | ((vkk & 4) << 1) | ((vkk & 8) >> 1);
  const int vsrc = vk * ldk + (((tid >> 5) & 3) << 5) + ((tid & 3) << 3);
  const unsigned ldsw = (unsigned)wid * 1024u;
  const bool kneed = (DHI - DLO == 8) || (((tid >> 3) & 1) == (DLO ? 1 : 0));
  const int vb0 = (int)(unsigned)(uintptr_t)V_lds + v_rd_base(lane);
  const int wrow0 = qpos0 + wid * 32, trow = wrow0 + r32;
  float m_reg = -1e30f, l_reg = 0.f, R = 1.0f;
  ATT_LAS int* dflag = (ATT_LAS int*)(lds + SCR_OFF + 8 * 64 * 4) + (par & 1) * 8;
  bool wdone = false;
  if (STRICT && lane == 0) dflag[wid] = -1;
#define ATT_DMA(t) do { const bf16_t* kg_ = Kb + (size_t)(64 * (t)) * ldk + ksrc; const bf16_t* vg_ = Vb + (size_t)(64 * (t)) * ldk + vsrc; const int b_ = (t) & 3; \
    if (kneed) { __builtin_amdgcn_global_load_lds((const unsigned*)kg_, (ATT_LAS unsigned*)(K_lds + b_ * SHM_K + ldsw), 16, 0, 0); \
    __builtin_amdgcn_global_load_lds((const unsigned*)(kg_ + 32 * ldk), (ATT_LAS unsigned*)(K_lds + b_ * SHM_K + ldsw + 8192), 16, 0, 0); } \
    __builtin_amdgcn_global_load_lds((const unsigned*)vg_, (ATT_LAS unsigned*)(V_lds + b_ * SHM_V + ldsw), 16, 0, 0); \
    __builtin_amdgcn_global_load_lds((const unsigned*)(vg_ + 32 * ldk), (ATT_LAS unsigned*)(V_lds + b_ * SHM_V + ldsw + 8192), 16, 0, 0); } while (0)
  ATT_DMA(nt - 1); ATT_DMA(nt - 2); asm volatile("s_waitcnt vmcnt(0)" ::: "memory"); __syncthreads();
  for (int jj = nt - 1; jj >= 1; jj -= 2) {
   if (jj >= 3) { ATT_DMA(jj - 2); ATT_DMA(jj - 3); }
#ifdef ATT_STAGGER
   if (wid >= 4) __builtin_amdgcn_s_sleep(ATT_STAGGER);
#endif
#pragma unroll
   for (int sub = 0; sub < 2; ++sub) {
    const int j = jj - sub, b = j & 3, kbase = 64 * j;
    bool skip = false, needmask = false;
    if (CAUSAL) { skip = kbase > wrow0 + 31; needmask = kbase + 63 > wrow0; }
    if (STRICT) { skip = kbase >= wrow0 + 31; needmask = kbase + 63 >= wrow0; }
    if (!skip && !wdone) {
      f32x16 p0, p1; bf16x8 pa0, pa1, pa2, pa3;
      qkt<DLO, DHI>(p0, p1, K_lds + b * SHM_K, qr, r32, hi);
#ifdef ATT_VPRE
      VFrag vfa, vfb; ATT_SBAR(); pv_pre(vfa, vfb, vb0 + b * SHM_V); ATT_SBAR();
#endif
      const int dd = trow - kbase - 4 * hi;
      if (SOFT) {
        if (CAUSAL && needmask) {
#pragma unroll
          for (int r = 0; r < 16; ++r) { const int cr = (r & 3) + 8 * (r >> 2); if (cr > dd) p0[r] = -INFINITY; if (cr + 32 > dd) p1[r] = -INFINITY; }
        }
        float pmax = p0[0];
#pragma unroll
        for (int r = 1; r < 16; ++r) pmax = fmaxf(pmax, p0[r]);
#pragma unroll
        for (int r = 0; r < 16; ++r) pmax = fmaxf(pmax, p1[r]);
        { auto rr = __builtin_amdgcn_permlane32_swap(__float_as_uint(pmax), __float_as_uint(pmax), false, false); pmax = fmaxf(__uint_as_float(rr[0]), __uint_as_float(rr[1])); }
        float mn, alpha;
        if (__builtin_expect(__all(pmax - m_reg <= 11.5f), 1)) { mn = m_reg; alpha = 1.f; }
        else { mn = fmaxf(m_reg, pmax); alpha = __builtin_amdgcn_exp2f(m_reg - mn); m_reg = mn; }
#pragma unroll
        for (int r = 0; r < 16; ++r) { p0[r] = __builtin_amdgcn_exp2f(p0[r] - mn); p1[r] = __builtin_amdgcn_exp2f(p1[r] - mn); }
        float ps = 0.f;
#pragma unroll
        for (int r = 0; r < 16; ++r) ps += p0[r];
#pragma unroll
        for (int r = 0; r < 16; ++r) ps += p1[r];
        { auto rr = __builtin_amdgcn_permlane32_swap(__float_as_uint(ps), __float_as_uint(ps), false, false); ps = __uint_as_float(rr[0]) + __uint_as_float(rr[1]); }
        l_reg = l_reg * alpha + ps;
        if (__any(alpha < 1.f)) { if (hi == 0) al_l[r32] = alpha; asm volatile("s_waitcnt lgkmcnt(0)" ::: "memory");
#pragma unroll
          for (int r = 0; r < 16; ++r) { const float a = al_l[crow(r, hi)];
#pragma unroll
            for (int d = 0; d < 4; ++d) o[d][r] *= a; }
          asm volatile("s_waitcnt lgkmcnt(0)" ::: "memory"); }
      } else {
        f32x16 q0, q1;
#pragma unroll
        for (int r = 0; r < 16; ++r) {
          { const float u = fmaxf(p0[r], -80.f), s = __builtin_amdgcn_exp2f(-u), rc = __builtin_amdgcn_rcpf(1.0f + s); p0[r] = rc; q0[r] = s * rc; }
          { const float u = fmaxf(p1[r], -80.f), s = __builtin_amdgcn_exp2f(-u), rc = __builtin_amdgcn_rcpf(1.0f + s); p1[r] = rc; q1[r] = s * rc; } }
        if (needmask) {
#pragma unroll
          for (int r = 0; r < 16; ++r) { const int cr = (r & 3) + 8 * (r >> 2);
            if (!(cr < dd)) { p0[r] = 0.f; q0[r] = 1.f; } if (!(cr + 32 < dd)) { p1[r] = 0.f; q1[r] = 1.f; } }
        }
        float tot[8];
#pragma unroll
        for (int c = 0; c < 4; ++c) { tot[c] = (q0[4 * c] * q0[4 * c + 1]) * (q0[4 * c + 2] * q0[4 * c + 3]); tot[4 + c] = (q1[4 * c] * q1[4 * c + 1]) * (q1[4 * c + 2] * q1[4 * c + 3]); }
        float run = R;
#pragma unroll
        for (int c = 7; c >= 0; --c) {
          auto rr = __builtin_amdgcn_permlane32_swap(__float_as_uint(tot[c]), __float_as_uint(tot[c]), false, false);
          const float Tlo = __uint_as_float(rr[0]), Thi = __uint_as_float(rr[1]);
          const float r1 = run, r0 = r1 * Thi;
          const float e3 = hi ? r1 : r0;
          if (c < 4) { const float e2 = e3 * q0[4 * c + 3], e1 = e2 * q0[4 * c + 2], e0 = e1 * q0[4 * c + 1];
            p0[4 * c + 3] *= e3; p0[4 * c + 2] *= e2; p0[4 * c + 1] *= e1; p0[4 * c] *= e0; }
          else { const int cc = c - 4; const float e2 = e3 * q1[4 * cc + 3], e1 = e2 * q1[4 * cc + 2], e0 = e1 * q1[4 * cc + 1];
            p1[4 * cc + 3] *= e3; p1[4 * cc + 2] *= e2; p1[4 * cc + 1] *= e1; p1[4 * cc] *= e0; }
          run = r0 * Tlo;
        }
        R = run;
      }
      pack_p(p0, p1, pa0, pa1, pa2, pa3);
#ifdef ATT_VPRE
      pv_post(o, vfa, vfb, vb0 + b * SHM_V, pa0, pa1, pa2, pa3);
#else
      pv_d0(o, vb0 + b * SHM_V, pa0, pa1, pa2, pa3);
#endif
      if (STRICT) { if (__all(R < SB_EPS)) { wdone = true; if (lane == 0) dflag[wid] = j; } }
    }
   }
    asm volatile("s_waitcnt vmcnt(0)" ::: "memory");
    __syncthreads();
    if (STRICT) { bool all = true;
#pragma unroll
      for (int w = 0; w < 8; ++w) all = all && (dflag[w] >= jj - 1);
      if (__builtin_amdgcn_readfirstlane((int)all)) break; }
  }
#undef ATT_DMA
  if (SOFT) {
    if (hi == 0) li_l[r32] = l_reg; asm volatile("s_waitcnt lgkmcnt(0)" ::: "memory");
#pragma unroll
    for (int r = 0; r < 16; ++r) { const float rl = __builtin_amdgcn_rcpf(li_l[crow(r, hi)]);
#pragma unroll
      for (int d = 0; d < 4; ++d) o[d][r] *= rl; }
    asm volatile("s_waitcnt lgkmcnt(0)" ::: "memory");
  }
}
template <bool NORM> __device__ __forceinline__ void store_rows(const f32x16 (&o)[4], const float* __restrict__ gain, float gscale, bf16_t* __restrict__ out, int ld, size_t cs, ATT_LAS char* lds) {
  int tl = threadIdx.x; asm volatile("" : "+v"(tl));
  const int lane = tl & 63, r32 = lane & 31, hi = lane >> 5, wid = __builtin_amdgcn_readfirstlane(tl >> 6);
  ATT_LAS char* stg = lds + (wid < 4 ? wid * 8192 : NBUF * SHM_V + (wid - 4) * 8192);
  float g[4] = {1.f, 1.f, 1.f, 1.f};
  if (NORM) {
#pragma unroll
    for (int d = 0; d < 4; ++d) g[d] = gain[32 * d + r32] * gscale; }
#pragma unroll
  for (int r = 0; r < 16; ++r) {
    float inv = 1.f;
    if (NORM) { float ss = (o[0][r] * o[0][r] + o[1][r] * o[1][r]) + (o[2][r] * o[2][r] + o[3][r] * o[3][r]);
      ss += __shfl_xor(ss, 1); ss += __shfl_xor(ss, 2); ss += __shfl_xor(ss, 4); ss += __shfl_xor(ss, 8); ss += __shfl_xor(ss, 16);
      inv = __builtin_amdgcn_rsqf(ss * (1.0f / 128.0f) + 1e-6f); }
    ATT_LAS bf16_t* rowp = (ATT_LAS bf16_t*)(stg + crow(r, hi) * 256) + r32;
#pragma unroll
    for (int d = 0; d < 4; ++d) { const float v = o[d][r] * inv * g[d]; rowp[32 * d] = (bf16_t)(cvtpk(v, v) & 0xffffu); }
  }
  asm volatile("s_waitcnt lgkmcnt(0)" ::: "memory");
#pragma unroll
  for (int k = 0; k < 8; ++k) { const int q = lane + 64 * k, row = q >> 4, piece = q & 15;
    const u32x4 w = *(const ATT_LAS u32x4*)(stg + row * 256 + piece * 16);
    *(u32x4*)(out + (size_t)row * ld + (size_t)(piece >> 3) * cs + (piece & 7) * 8) = w; }
  asm volatile("s_waitcnt lgkmcnt(0)" ::: "memory");
  __syncthreads();
}
}

constexpr int NWAVES = 8;
constexpr int S_ = 8192, D_ = 4096, FF_ = 14336, INW = 12288, MEMT = 256, XW = 512;
constexpr float NORM_EPS = 1e-6f;
#ifndef REP_P0
#define REP_P0 1
#endif
#ifndef REP_P1
#define REP_P1 1
#endif
#ifndef REP_P2
#define REP_P2 1
#endif
#ifndef REP_P3
#define REP_P3 1
#endif
#ifndef REP_P4
#define REP_P4 1
#endif
#ifndef REP_P6
#define REP_P6 1
#endif
#ifndef REP_P5
#define REP_P5 1
#endif
#ifndef CONV_P1
#define CONV_P1 0
#endif
#ifndef PG8_SP2V
#define PG8_SP2V true
#endif
#ifndef PG8_ALIGNV
#define PG8_ALIGNV true
#endif
#ifndef CONV_FP8
#define CONV_FP8 2
#endif
static_assert(CONV_FP8 >= 1, "the FFN2 gate|up GEMM reads the e4m3 rows the last pre-norm writes");
#ifndef STOP_AFTER
#define STOP_AFTER 99
#endif

constexpr size_t MiB = 1u << 20;
constexpr size_t WS_CTL = 0, CTL_ZERO_BYTES = 64 * 1024;
constexpr size_t WS_ROPE = 1 * MiB;
constexpr size_t WS_MEMN = 2 * MiB;
constexpr size_t WS_KV = 4 * MiB;
constexpr size_t WS_XQ = 5 * MiB;
constexpr size_t WS_XO = 13 * MiB;
constexpr size_t WS_SCR = 21 * MiB;
constexpr size_t WS_WQ = 53 * MiB, WS_WKV = 57 * MiB, WS_WO = 65 * MiB, WS_WOUT = 69 * MiB, WS_WIN = 101 * MiB;
constexpr size_t WS_WGU1 = 197 * MiB, WS_WD1 = 421 * MiB, WS_WGU2 = 533 * MiB, WS_WD2 = 757 * MiB;
constexpr size_t WS_XN = 869 * MiB;
constexpr size_t WS_MERGED = 933 * MiB;
constexpr size_t WS_Y = 997 * MiB;
constexpr size_t WS_XN8 = 1061 * MiB;
constexpr size_t WS_RSTD = 1 * MiB + 512 * 1024;
constexpr size_t WS_HID = 1125 * MiB;
constexpr size_t WS_SSP = 1349 * MiB;
constexpr size_t WS_END = 1351 * MiB;
constexpr int CW_BAR = 4096;

constexpr int RING_BYTES = 131072, MISC_OFF = RING_BYTES + 320, LDS_BYTES = 147456;

#define GAS __attribute__((address_space(1)))
#define LAS __attribute__((address_space(3)))
typedef unsigned short bf16;
typedef unsigned v4u __attribute__((ext_vector_type(4)));
typedef unsigned v2u __attribute__((ext_vector_type(2)));
typedef float f32x4 __attribute__((ext_vector_type(4)));
typedef float f32x2 __attribute__((ext_vector_type(2)));
typedef GAS unsigned gu32;

#define XB_TMO      128
#define XB_XCNT(j)  (256  + 64 * (j))
#define XB_XSUB(j)  (1280 + 64 * (j))
#define XB_XGEN(j)  (2304 + 64 * (j))
#define XB_TOP      3328
#define XB_TOPGEN   3392
#define XCD_BAR_WORDS 3456
#define XB_SPIN_CAP (1u << 18)

__device__ __forceinline__ unsigned xb_ld(unsigned* p)              { return __hip_atomic_load(p, __ATOMIC_RELAXED, __HIP_MEMORY_SCOPE_AGENT); }
__device__ __forceinline__ unsigned xb_add(unsigned* p, unsigned v) { return __hip_atomic_fetch_add(p, v, __ATOMIC_RELAXED, __HIP_MEMORY_SCOPE_AGENT); }
__device__ __forceinline__ unsigned xb_xcc_id() { return (unsigned)__builtin_amdgcn_s_getreg((3 << 11) | 20) & 0xFu; }
#define XB_SPIN(cond, bar) do { unsigned _sp = 0; while (cond) { __builtin_amdgcn_s_sleep(1); \
    if ((++_sp & 255u) == 0u) { if (xb_ld(&(bar)[XB_TMO])) break; if (_sp > XB_SPIN_CAP) { atomicAdd(&(bar)[XB_TMO], 1u); break; } } } } while (0)

struct XcdBarrier {
    unsigned* bar; unsigned x;
    volatile LAS unsigned* st;
};
__device__ __forceinline__ XcdBarrier xcd_barrier_post(unsigned* bar, volatile LAS unsigned* st) {
    XcdBarrier b; b.bar = bar; b.x = xb_xcc_id(); b.st = st;
    if (threadIdx.x == 0) (void)xb_add(&bar[XB_XCNT(b.x)], 1u);
    return b;
}
__device__ __forceinline__ void xcd_barrier_complete(unsigned* bar, unsigned x, unsigned& nloc, unsigned& nx) {
    const unsigned G = gridDim.x * gridDim.y * gridDim.z;
    unsigned sum, cnt, mine, sp = 0u;
    for (;;) {
        sum = 0u; cnt = 0u; mine = 0u;
#pragma unroll
        for (unsigned j = 0; j < 16; ++j) { const unsigned c = xb_ld(&bar[XB_XCNT(j)]); sum += c; cnt += (c > 0u) ? 1u : 0u; mine = (j == x) ? c : mine; }
        if (sum == G) break;
        __builtin_amdgcn_s_sleep(1);
        if ((++sp & 255u) == 0u) { if (xb_ld(&bar[XB_TMO])) break; if (sp > XB_SPIN_CAP) { atomicAdd(&bar[XB_TMO], 1u); break; } }
    }
    nloc = mine > 0u ? mine : 1u; nx = cnt > 0u ? cnt : 1u;
}
__device__ __forceinline__ void xcd_barrier(const XcdBarrier& b) {
    asm volatile("s_waitcnt vmcnt(0)" ::: "memory");
    __syncthreads();
    if (threadIdx.x == 0) {
        unsigned* bar = b.bar;
        __builtin_amdgcn_s_waitcnt(0);
        unsigned nloc = b.st[0], nx = b.st[1];
        if (nloc == 0u) { xcd_barrier_complete(bar, b.x, nloc, nx); b.st[0] = nloc; b.st[1] = nx; }
        const unsigned old = xb_add(&bar[XB_XSUB(b.x)], 1u);
        const unsigned gen = old / nloc;
        if (old + 1u == (gen + 1u) * nloc) {
            __builtin_amdgcn_fence(__ATOMIC_RELEASE, "agent");
            asm volatile("s_waitcnt vmcnt(0)" ::: "memory");
            const unsigned og = xb_add(&bar[XB_TOP], 1u);
            const unsigned tg = og / nx;
            if (og + 1u == (tg + 1u) * nx) xb_add(&bar[XB_TOPGEN], 1u);
            else XB_SPIN(xb_ld(&bar[XB_TOPGEN]) == tg, bar);
            __builtin_amdgcn_fence(__ATOMIC_ACQUIRE, "agent");
            xb_add(&bar[XB_XGEN(b.x)], 1u);
            asm volatile("s_waitcnt vmcnt(0)" ::: "memory");
        } else {
            XB_SPIN(xb_ld(&bar[XB_XGEN(b.x)]) == gen, bar);
            __builtin_amdgcn_fence(__ATOMIC_ACQUIRE, "agent");
            asm volatile("s_waitcnt vmcnt(0)" ::: "memory");
        }
    }
    __syncthreads();
}

__device__ __forceinline__ float wave_sum(float v) {
#pragma unroll
    for (int o = 1; o < 64; o <<= 1) v += __shfl_xor(v, o);
    return v;
}
__device__ __forceinline__ unsigned pkbf(float lo, float hi) { unsigned r; asm volatile("v_cvt_pk_bf16_f32 %0, %1, %2" : "=v"(r) : "v"(lo), "v"(hi)); return r; }

__device__ __forceinline__ void tr_item(const float* __restrict__ W, int K, int N, bf16* __restrict__ WT, int NT, int gmul, int goff, LAS unsigned* scr, int item, int lane, const float* __restrict__ gk) {
    { int t_ = threadIdx.x; asm volatile("" : "+v"(t_)); lane = t_ & 63; }
    const int nblk = N >> 6, kb = item / nblk, nb = item - kb * nblk, k0 = kb << 6, n0 = nb << 6;
    const int q = lane >> 4, c4 = (lane & 15) * 4;
    const float* src = W + (size_t)(k0 + 2 * q) * N + n0 + c4;
    f32x4 a[8], b[8]; f32x2 gg[8];
#pragma unroll
    for (int i = 0; i < 8; ++i) { a[i] = *(const f32x4*)(src + (size_t)(8 * i) * N); b[i] = *(const f32x4*)(src + (size_t)(8 * i + 1) * N); gg[i] = *(const f32x2*)(gk + k0 + 2 * q + 8 * i); }
#pragma unroll
    for (int i = 0; i < 8; ++i) { const int kp = 4 * i + q; const f32x4 av = a[i] * gg[i][0], bv = b[i] * gg[i][1];
        scr[(c4 + 0) * 33 + kp] = pkbf(av[0], bv[0]); scr[(c4 + 1) * 33 + kp] = pkbf(av[1], bv[1]);
        scr[(c4 + 2) * 33 + kp] = pkbf(av[2], bv[2]); scr[(c4 + 3) * 33 + kp] = pkbf(av[3], bv[3]); }
    asm volatile("s_waitcnt lgkmcnt(0)" ::: "memory");
    const int c = lane & 7;
#pragma unroll
    for (int jj = 0; jj < 8; ++jj) { const int n = (lane >> 3) + 8 * jj; const LAS unsigned* s = scr + n * 33 + 4 * c;
        v4u o; o.x = s[0]; o.y = s[1]; o.z = s[2]; o.w = s[3];
        const int nn = n0 + n; const int nrow = nn + gmul * (nn & ~127) + goff;
        *(v4u*)(WT + ((size_t)kb * NT + nrow) * 64 + 8 * c) = o; }
    asm volatile("s_waitcnt lgkmcnt(0)" ::: "memory");
}
struct ConvList { const float *wd1, *wkv, *win, *wout, *wq, *wo, *wg2, *wu2, *wd2; bf16 *WD1, *WKV, *WIN, *WOUT, *WQ, *WO, *WGU2, *WD2; const float *gwin, *gwq; };
constexpr int CI_GU = (D_ / 64) * (FF_ / 64), CI_DN = CI_GU, CI_IN = (D_ / 64) * (INW / 64), CI_OUT = (D_ / 64) * (D_ / 64), CI_Q = (D_ / 64) * (XW / 64), CI_KV = (D_ / 64) * (2 * XW / 64), CI_O = (XW / 64) * (D_ / 64);
constexpr int CE_WD1 = CI_DN, CE_WKV = CE_WD1 + CI_KV, CE_WIN = CE_WKV + CI_IN, CE_WOUT = CE_WIN + CI_OUT, CE_WQ = CE_WOUT + CI_Q, CE_WO = CE_WQ + CI_O, CE_WGU2 = CE_WO + 2 * CI_GU, CE_ALL = CE_WGU2 + CI_DN;
constexpr int CW_CONV = 2048;
struct ConvJob { const float* W; bf16* WT; const float* gk; int K, N, gmul, goff, item; };
__device__ __forceinline__ ConvJob conv_decode(const ConvList& L, int gi) {
    ConvJob j; j.gmul = 0; j.goff = 0; j.gk = nullptr; int r = gi;
    if (r < CE_WD1) { j.W = L.wd1; j.WT = L.WD1; j.K = FF_; j.N = D_; }
    else if (r < CE_WKV) { r -= CE_WD1; j.W = L.wkv; j.WT = L.WKV; j.K = D_; j.N = 2 * XW; }
    else if (r < CE_WIN) { r -= CE_WKV; j.W = L.win; j.WT = L.WIN; j.K = D_; j.N = INW; j.gk = L.gwin; }
    else if (r < CE_WOUT) { r -= CE_WIN; j.W = L.wout; j.WT = L.WOUT; j.K = D_; j.N = D_; }
    else if (r < CE_WQ) { r -= CE_WOUT; j.W = L.wq; j.WT = L.WQ; j.K = D_; j.N = XW; j.gk = L.gwq; }
    else if (r < CE_WO) { r -= CE_WQ; j.W = L.wo; j.WT = L.WO; j.K = XW; j.N = D_; }
    else if (r < CE_WO + CI_GU) { r -= CE_WO; j.W = L.wg2; j.WT = L.WGU2; j.K = D_; j.N = FF_; j.gmul = 1; }
    else if (r < CE_WGU2) { r -= CE_WO + CI_GU; j.W = L.wu2; j.WT = L.WGU2; j.K = D_; j.N = FF_; j.gmul = 1; j.goff = 128; }
    else { r -= CE_WGU2; j.W = L.wd2; j.WT = L.WD2; j.K = FF_; j.N = D_; }
    j.item = r; return j;
}
__device__ __forceinline__ void tr_load(const ConvJob& j, f32x4 (&a)[8], f32x4 (&b)[8], f32x2 (&gg)[8], int lane) {
    const int nblk = j.N >> 6, kb = j.item / nblk, nb = j.item - kb * nblk, k0 = kb << 6, n0 = nb << 6;
    const int q = lane >> 4, c4 = (lane & 15) * 4;
    const float* src = j.W + (size_t)(k0 + 2 * q) * j.N + n0 + c4;
#pragma unroll
    for (int i = 0; i < 8; ++i) { a[i] = __builtin_nontemporal_load((const f32x4*)(src + (size_t)(8 * i) * j.N)); b[i] = __builtin_nontemporal_load((const f32x4*)(src + (size_t)(8 * i + 1) * j.N)); }
    if (j.gk) {
#pragma unroll
        for (int i = 0; i < 8; ++i) gg[i] = *(const f32x2*)(j.gk + k0 + 2 * q + 8 * i); }
    else {
#pragma unroll
        for (int i = 0; i < 8; ++i) gg[i] = (f32x2){1.0f, 1.0f}; }
}
__device__ __forceinline__ void tr_finish(const ConvJob& j, const f32x4 (&a)[8], const f32x4 (&b)[8], const f32x2 (&gg)[8], LAS unsigned* scr, int lane) {
    const int nblk = j.N >> 6, kb = j.item / nblk, nb = j.item - kb * nblk, k0 = kb << 6, n0 = nb << 6;
    const int q = lane >> 4, c4 = (lane & 15) * 4;
#pragma unroll
    for (int i = 0; i < 8; ++i) { const int kp = 4 * i + q; const f32x4 av = a[i] * gg[i][0], bv = b[i] * gg[i][1];
        scr[(c4 + 0) * 33 + kp] = pkbf(av[0], bv[0]); scr[(c4 + 1) * 33 + kp] = pkbf(av[1], bv[1]);
        scr[(c4 + 2) * 33 + kp] = pkbf(av[2], bv[2]); scr[(c4 + 3) * 33 + kp] = pkbf(av[3], bv[3]); }
    asm volatile("s_waitcnt lgkmcnt(0)" ::: "memory");
    const int c = lane & 7;
#pragma unroll
    for (int jj = 0; jj < 8; ++jj) { const int n = (lane >> 3) + 8 * jj; const LAS unsigned* s = scr + n * 33 + 4 * c;
        v4u o; o.x = s[0]; o.y = s[1]; o.z = s[2]; o.w = s[3];
        const int nn = n0 + n; const int nrow = nn + j.gmul * (nn & ~127) + j.goff;
        __builtin_nontemporal_store(o, (v4u*)(j.WT + ((size_t)kb * (j.N << j.gmul) + nrow) * 64 + 8 * c)); }
    asm volatile("s_waitcnt lgkmcnt(0)" ::: "memory");
}
__device__ __forceinline__ unsigned pk4_fp8(float a, float b, float c, float d) { int w = __builtin_amdgcn_cvt_pk_fp8_f32(a, b, 0, false); w = __builtin_amdgcn_cvt_pk_fp8_f32(c, d, w, true); return (unsigned)w; }
__device__ __forceinline__ void tr_item8(const ConvJob& j, LAS unsigned* scr, int lane) {
    const int nblk = j.N >> 6, kb = j.item / nblk, nb = j.item - kb * nblk, k0 = kb << 6, n0 = nb << 6;
    const int q = lane >> 4, c4 = (lane & 15) * 4;
    const float* src = j.W + (size_t)(k0 + 4 * q) * j.N + n0 + c4;
    f32x4 r[4][4];
#pragma unroll
    for (int i = 0; i < 4; ++i)
#pragma unroll
        for (int e = 0; e < 4; ++e) r[i][e] = __builtin_nontemporal_load((const f32x4*)(src + (size_t)(16 * i + e) * j.N));
#pragma unroll
    for (int i = 0; i < 4; ++i) { const int kq = 4 * i + q;
#pragma unroll
        for (int jn = 0; jn < 4; ++jn) scr[(c4 + jn) * 17 + kq] = pk4_fp8(r[i][0][jn] * 256.0f, r[i][1][jn] * 256.0f, r[i][2][jn] * 256.0f, r[i][3][jn] * 256.0f); }
    asm volatile("s_waitcnt lgkmcnt(0)" ::: "memory");
    const int c = lane & 3;
#pragma unroll
    for (int jj = 0; jj < 4; ++jj) { const int n = (lane >> 2) + 16 * jj; const LAS unsigned* sp = scr + n * 17 + 4 * c;
        v4u o; o.x = sp[0]; o.y = sp[1]; o.z = sp[2]; o.w = sp[3];
        const int nn = n0 + n; const int nrow = nn + j.gmul * (nn & ~127) + j.goff;
        __builtin_nontemporal_store(o, (v4u*)((unsigned char*)j.WT + ((size_t)(kb >> 1) * (j.N << j.gmul) + nrow) * 128 + (kb & 1) * 64 + 16 * c)); }
    asm volatile("s_waitcnt lgkmcnt(0)" ::: "memory");
}
constexpr int CONV_CHUNK = 32, CONV_PER_WAVE = CONV_CHUNK / NWAVES;
static_assert(CE_WO % CONV_CHUNK == 0 && CE_WGU2 % CONV_CHUNK == 0, "a wave's items are all of one kind");
static_assert(CE_ALL % CONV_CHUNK == 0, "whole chunks");
__device__ __forceinline__ void conv_pull(const ConvList& L, gu32* ctr, int limit, gu32* stop, volatile LAS unsigned* slot, LAS unsigned* scr, int tid, int wave, int lane) {
    { int t_ = threadIdx.x; asm volatile("" : "+v"(t_)); tid = t_; lane = t_ & 63; }
    for (int iter = 0;; ++iter) {
        if (tid == 0) { unsigned b = 0xffffffffu;
            const bool halt = stop != nullptr && __hip_atomic_load(stop, __ATOMIC_RELAXED, __HIP_MEMORY_SCOPE_AGENT) != 0u;
            if (!halt && (int)__hip_atomic_load(ctr, __ATOMIC_RELAXED, __HIP_MEMORY_SCOPE_AGENT) < limit) b = __hip_atomic_fetch_add(ctr, (unsigned)CONV_CHUNK, __ATOMIC_RELAXED, __HIP_MEMORY_SCOPE_AGENT); slot[iter & 1] = b; }
        __syncthreads();
        const unsigned base = slot[iter & 1];
        if (base >= (unsigned)CE_ALL) break;
        const int g0 = (int)base + wave * CONV_PER_WAVE;
        if (CONV_FP8 && g0 >= CE_WO && g0 < (CONV_FP8 >= 2 ? CE_ALL : CE_WGU2)) {
#pragma unroll 1
            for (int k = 0; k < CONV_PER_WAVE; ++k) { const ConvJob j8 = conv_decode(L, g0 + k); tr_item8(j8, scr, lane); }
            continue; }
        f32x4 a0[8], b0[8], a1[8], b1[8]; f32x2 gg0[8], gg1[8];
        ConvJob j0 = conv_decode(L, g0), j1;
        tr_load(j0, a0, b0, gg0, lane);
#pragma unroll 1
        for (int k = 0; k < CONV_PER_WAVE; k += 2) {
            j1 = conv_decode(L, g0 + k + 1); tr_load(j1, a1, b1, gg1, lane);
            tr_finish(j0, a0, b0, gg0, scr, lane);
            if (k + 2 < CONV_PER_WAVE) { j0 = conv_decode(L, g0 + k + 2); tr_load(j0, a0, b0, gg0, lane); }
            tr_finish(j1, a1, b1, gg1, scr, lane);
        }
    }
    __syncthreads();
}
#define NR_LD(p, j) (((const f32x4*)((p) + 256 * (j)))[lane])
#define NR_FENCE() asm volatile("" ::: "memory")
template <bool HAS_Y, bool WRITE_H, bool WRITE_XN, bool RAW = false>
__device__ __forceinline__ void norm_row(const float* hin, const float* __restrict__ y, float cy, const float* __restrict__ g_post, float* hout,
                                         const float* __restrict__ g_pre, bf16* __restrict__ xn, size_t xcs, int lane, float* rstd = nullptr) {
    f32x4 hv[16];
    if (HAS_Y) {
    { int t_ = threadIdx.x; asm volatile("" : "+v"(t_)); lane = t_ & 63; }
        float ss = 0.f;
#pragma unroll
        for (int c = 0; c < 2; ++c) { f32x4 yv[8];
#pragma unroll
            for (int j = 0; j < 8; ++j) yv[j] = NR_LD(y, 8 * c + j);
#pragma unroll
            for (int j = 0; j < 8; ++j) ss += (yv[j][0] * yv[j][0] + yv[j][1] * yv[j][1]) + (yv[j][2] * yv[j][2] + yv[j][3] * yv[j][3]);
            NR_FENCE(); }
        const float ry = cy * __builtin_amdgcn_rsqf(wave_sum(ss) * (1.0f / 4096.0f) + NORM_EPS);
#pragma unroll
        for (int c = 0; c < 4; ++c) { f32x4 yv[4], gv[4];
#pragma unroll
            for (int j = 0; j < 4; ++j) { hv[4 * c + j] = NR_LD(hin, 4 * c + j); yv[j] = NR_LD(y, 4 * c + j); gv[j] = NR_LD(g_post, 4 * c + j); }
#pragma unroll
            for (int j = 0; j < 4; ++j) { hv[4 * c + j] = hv[4 * c + j] + (yv[j] * ry) * gv[j]; if (WRITE_H) ((f32x4*)(hout + 256 * (4 * c + j)))[lane] = hv[4 * c + j]; }
            NR_FENCE(); }
    } else {
#pragma unroll
        for (int c = 0; c < 2; ++c) {
#pragma unroll
            for (int j = 0; j < 8; ++j) hv[8 * c + j] = NR_LD(hin, 8 * c + j);
            NR_FENCE(); }
        if (WRITE_H) {
#pragma unroll
            for (int j = 0; j < 16; ++j) ((f32x4*)(hout + 256 * j))[lane] = hv[j]; }
    }
    if (WRITE_XN) {
        float ss = 0.f;
#pragma unroll
        for (int j = 0; j < 16; ++j) ss += (hv[j][0] * hv[j][0] + hv[j][1] * hv[j][1]) + (hv[j][2] * hv[j][2] + hv[j][3] * hv[j][3]);
        const float rh = __builtin_amdgcn_rsqf(wave_sum(ss) * (1.0f / 4096.0f) + NORM_EPS);
        if (RAW) { if (lane == 0) *rstd = rh; }
#pragma unroll
        for (int c = 0; c < 4; ++c) { f32x4 gv[4];
            if (!RAW) {
#pragma unroll
            for (int j = 0; j < 4; ++j) gv[j] = NR_LD(g_pre, 4 * c + j); }
#pragma unroll
            for (int j = 0; j < 4; ++j) { f32x4 v = hv[4 * c + j]; if (!RAW) v = (v * rh) * gv[j]; v2u w; w.x = pkbf(v[0], v[1]); w.y = pkbf(v[2], v[3]); *(v2u*)(xn + (size_t)(4 * (4 * c + j) + (lane >> 4)) * xcs + 4 * (lane & 15)) = w; }
            NR_FENCE(); }
    }
}

template <bool OUT32, bool FP8X>
__device__ __forceinline__ void norm_row2(bf16* xh, size_t xcs, const bf16* __restrict__ y, const float* __restrict__ ssp, float cy, const float* __restrict__ g_post, float* hout32,
                                          const float* __restrict__ g_pre, unsigned char* xn8, size_t x8cs, float* rstd, int lane) {
    { int t_ = threadIdx.x; asm volatile("" : "+v"(t_)); lane = t_ & 63; }
    const float ry = cy * __builtin_amdgcn_rsqf(wave_sum(ssp[lane]) * (1.0f / 4096.0f) + NORM_EPS);
    f32x4 hv[16];
#pragma unroll
    for (int c = 0; c < 4; ++c) { v2u yb[4], hb[4]; f32x4 gv[4];
#pragma unroll
        for (int j = 0; j < 4; ++j) { hb[j] = *(const v2u*)(xh + (size_t)(4 * (4 * c + j) + (lane >> 4)) * xcs + 4 * (lane & 15));
            yb[j] = ((const v2u*)(y + 256 * (4 * c + j)))[lane]; gv[j] = NR_LD(g_post, 4 * c + j); }
#pragma unroll
        for (int j = 0; j < 4; ++j) { const f32x4 yv = {__uint_as_float(yb[j].x << 16), __uint_as_float(yb[j].x & 0xffff0000u), __uint_as_float(yb[j].y << 16), __uint_as_float(yb[j].y & 0xffff0000u)};
            const f32x4 h0 = {__uint_as_float(hb[j].x << 16), __uint_as_float(hb[j].x & 0xffff0000u), __uint_as_float(hb[j].y << 16), __uint_as_float(hb[j].y & 0xffff0000u)};
            hv[4 * c + j] = h0 + (yv * ry) * gv[j];
            if (OUT32) ((f32x4*)(hout32 + 256 * (4 * c + j)))[lane] = hv[4 * c + j];
            else { v2u w; w.x = pkbf(hv[4 * c + j][0], hv[4 * c + j][1]); w.y = pkbf(hv[4 * c + j][2], hv[4 * c + j][3]); *(v2u*)(xh + (size_t)(4 * (4 * c + j) + (lane >> 4)) * xcs + 4 * (lane & 15)) = w; } }
        NR_FENCE(); }
    if (!OUT32) {
        float ss = 0.f;
#pragma unroll
        for (int j = 0; j < 16; ++j) ss += (hv[j][0] * hv[j][0] + hv[j][1] * hv[j][1]) + (hv[j][2] * hv[j][2] + hv[j][3] * hv[j][3]);
        const float rh = __builtin_amdgcn_rsqf(wave_sum(ss) * (1.0f / 4096.0f) + NORM_EPS);
        if (!FP8X) { if (lane == 0) *rstd = rh; }
        else {
#pragma unroll
        for (int c = 0; c < 4; ++c) { f32x4 gv[4];
#pragma unroll
            for (int j = 0; j < 4; ++j) gv[j] = NR_LD(g_pre, 4 * c + j);
#pragma unroll
            for (int j = 0; j < 4; ++j) { const f32x4 v = (hv[4 * c + j] * rh) * gv[j];
                *(unsigned*)(xn8 + (size_t)(2 * (4 * c + j) + (lane >> 5)) * x8cs + 4 * (lane & 31)) = pk4_fp8(v[0], v[1], v[2], v[3]); }
            NR_FENCE(); } }
    }
}
__device__ __forceinline__ void sincos_d(float ang, float& sn, float& cs) {
    const double a = (double)ang, k = __builtin_rint(a * 0.15915494309189535);
    double r = __builtin_fma(-k, 6.283185307179586, a); r = __builtin_fma(-k, 2.4492935982947064e-16, r);
    const double z = r * r;
    double sp = 1.0 / 1.0888869450418352e28;
    sp = sp * z - 1.0 / 1.5511210043330986e25;
    sp = sp * z + 1.0 / 2.5852016738884978e22;
    sp = sp * z - 1.0 / 5.109094217170944e19;
    sp = sp * z + 1.0 / 1.21645100408832e17;
    sp = sp * z - 1.0 / 3.55687428096e14;
    sp = sp * z + 1.0 / 1.307674368e12;
    sp = sp * z - 1.0 / 6.2270208e9;
    sp = sp * z + 1.0 / 3.99168e7;
    sp = sp * z - 1.0 / 362880.0;
    sp = sp * z + 1.0 / 5040.0;
    sp = sp * z - 1.0 / 120.0;
    sp = sp * z + 1.0 / 6.0;
    const double s = r - r * z * sp;
    double cp = 1.0 / 4.0329146112660565e26;
    cp = cp * z - 1.0 / 6.204484017332394e23;
    cp = cp * z + 1.0 / 1.1240007277776077e21;
    cp = cp * z - 1.0 / 2.43290200817664e18;
    cp = cp * z + 1.0 / 6.402373705728e15;
    cp = cp * z - 1.0 / 2.0922789888e13;
    cp = cp * z + 1.0 / 8.71782912e10;
    cp = cp * z - 1.0 / 4.790016e8;
    cp = cp * z + 1.0 / 3628800.0;
    cp = cp * z - 1.0 / 40320.0;
    cp = cp * z + 1.0 / 720.0;
    cp = cp * z - 1.0 / 24.0;
    cp = cp * z + 0.5;
    const double c = 1.0 - z * cp;
    sn = (float)s; cs = (float)c;
}

__device__ __forceinline__ const float* karg(int i) { int ii = i; asm volatile("" : "+s"(ii)); return ((const float* const __attribute__((address_space(4)))*)__builtin_amdgcn_kernarg_segment_ptr())[ii]; }
struct Args {
    const float* in[29]; const int* pos; float* out; unsigned char* ws; float inv_freq[8]; int pad0, pad1;
};

__global__ void __launch_bounds__(NWAVES * 64, 2) mega_fwd(Args args) {
    extern __shared__ __attribute__((aligned(16))) unsigned char lds_raw[];
    LAS unsigned char* lds = (LAS unsigned char*)lds_raw;
    volatile LAS unsigned* MISC = (volatile LAS unsigned*)(lds + MISC_OFF);
    const int tid = threadIdx.x, lane = tid & 63, wave = __builtin_amdgcn_readfirstlane(tid >> 6);
    const int G = gridDim.x, bid = blockIdx.x;
    unsigned char* ws = args.ws;
    gu32* ctl = (gu32*)(ws + WS_CTL);
    for (int u = tid; u < (LDS_BYTES - RING_BYTES) / 4; u += NWAVES * 64) ((LAS unsigned*)(lds + RING_BYTES))[u] = 0u;
    __syncthreads();
    XcdBarrier bar = xcd_barrier_post((unsigned*)(ctl + CW_BAR), MISC + 8);
#define GRID_BAR() xcd_barrier(bar)

#define KARG(i) karg(i)
    float* out = args.out;
    float* ROPE = (float*)(ws + WS_ROPE); bf16* MEMN = (bf16*)(ws + WS_MEMN); bf16* KV = (bf16*)(ws + WS_KV); bf16* XQ = (bf16*)(ws + WS_XQ); bf16* XO = (bf16*)(ws + WS_XO);
    float* SCR = (float*)(ws + WS_SCR);
    bf16* WQ = (bf16*)(ws + WS_WQ); bf16* WKV = (bf16*)(ws + WS_WKV); bf16* WO = (bf16*)(ws + WS_WO); bf16* WOUT = (bf16*)(ws + WS_WOUT); bf16* WIN = (bf16*)(ws + WS_WIN);
    bf16* WGU1 = (bf16*)(ws + WS_WGU1); bf16* WD1 = (bf16*)(ws + WS_WD1); bf16* WGU2 = (bf16*)(ws + WS_WGU2); bf16* WD2 = (bf16*)(ws + WS_WD2);
    bf16* XN = (bf16*)(ws + WS_XN); bf16* MERGED = (bf16*)(ws + WS_MERGED); bf16* Y = (bf16*)(ws + WS_Y); float* SSP = (float*)(ws + WS_SSP); bf16* HID = (bf16*)(ws + WS_HID); bf16* PROJ = (bf16*)(ws + WS_HID); unsigned char* XN8 = ws + WS_XN8; float* RSTD = (float*)(ws + WS_RSTD);
    const int gw = bid * NWAVES + wave, NGW = G * NWAVES;
    gu32* cctr = ctl + CW_CONV; LAS unsigned* cscr = (LAS unsigned*)(lds + wave * 8448); volatile LAS unsigned* cslot = MISC + 16;
#define CONV_LIST() const ConvList CL{KARG(7), KARG(22), KARG(10), KARG(11), KARG(21), KARG(23), KARG(26), KARG(27), KARG(28), WD1, WKV, WIN, WOUT, WQ, WO, WGU2, WD2, KARG(8), KARG(18)}
#define CONV_DRAIN(lim) do { CONV_LIST(); conv_pull(CL, cctr, (lim), nullptr, cslot, cscr, tid, wave, lane); } while (0)
#define CONV_HELP(k) do { CONV_LIST(); conv_pull(CL, cctr, CE_ALL, ctl + CW_CONV + 64 * (k), cslot, cscr, tid, wave, lane); } while (0)
#define CONV_RAISE(k) do { if (tid == 0) __hip_atomic_store(ctl + CW_CONV + 64 * (k), 1u, __ATOMIC_RELAXED, __HIP_MEMORY_SCOPE_AGENT); } while (0)

#pragma unroll 1
    for (int rep = 0; rep < REP_P0; ++rep) {
        LAS unsigned* scr = (LAS unsigned*)(lds + wave * 8448);
        for (int it = gw; it < 2 * CI_GU; it += NGW) {
            if (it < CI_GU) tr_item(KARG(5), D_, FF_, WGU1, 2 * FF_, 1, 0, scr, it, lane, KARG(3)); else tr_item(KARG(6), D_, FF_, WGU1, 2 * FF_, 1, 128, scr, it - CI_GU, lane, KARG(3));
        }
        for (int m = gw; m < S_; m += NGW) norm_row<false, false, true, true>(KARG(0) + (size_t)m * D_, nullptr, 0.f, nullptr, nullptr, nullptr, XN + (size_t)m * 64, (size_t)S_ * 64, lane, RSTD + m);
        for (int m = gw; m < MEMT; m += NGW) norm_row<false, false, true>(KARG(1) + (size_t)m * D_, nullptr, 0.f, nullptr, nullptr, KARG(20), MEMN + (size_t)m * 64, (size_t)MEMT * 64, lane);
        for (int e = bid * (NWAVES * 64) + tid; e < S_ * 8; e += G * NWAVES * 64) { const int t = e >> 3, i = e & 7;
            const float ang = (float)args.pos[t] * args.inv_freq[i]; float sn, cs; sincos_d(ang, sn, cs); ROPE[t * 16 + i] = cs; ROPE[t * 16 + 8 + i] = sn; }
    }
    GRID_BAR();

    { const int NG1 = (G == 256 && CONV_P1) ? 240 : G;
      if (bid < NG1) {
#pragma unroll 1
        for (int rep = 0; rep < REP_P1; ++rep)
        { pg8::Gemm g{XN, WGU1, S_, 2 * FF_, D_}; pg8::StaticOrder S; S.init(S_, 2 * FF_, NG1, bid); pg8::EpiSwiGLU E{HID, FF_, S_, 1.0f, 0, RSTD};
          pg8::gemm_phase<pg8::EpiSwiGLU, pg8::StaticOrder, PG8_ALIGNV, PG8_SP2V, true>(lds, g, S, E); }
        CONV_RAISE(1);
      } else CONV_HELP(1);
      CONV_DRAIN(CE_WKV); }
    GRID_BAR();
#pragma unroll 1
    for (int rep = 0; rep < REP_P2; ++rep)
    { pg8::Gemm g{HID, WD1, S_, D_, FF_}; pg8::StaticOrder S; S.init(S_, D_, G, bid); pg8::EpiBf16SS E{Y, D_, SSP, 1.0f};
      pg8::gemm_phase<pg8::EpiBf16SS, pg8::StaticOrder, PG8_ALIGNV, PG8_SP2V, true>(lds, g, S, E); }
    GRID_BAR();
    if (bid < 4 && G > 8) { pg8::Gemm g{MEMN, WKV, MEMT, 2 * XW, D_}; pg8::RowOrder S{(2 * XW) / 256, 4, bid}; pg8::EpiBf16S E{KV, 2 * XW, 1.0f, nullptr};
      pg8::gemm_phase<pg8::EpiBf16S, pg8::RowOrder, false, true, true>(lds, g, S, E); }
    else { const int nb = G > 8 ? G - 4 : G, b0 = G > 8 ? bid - 4 : bid;
#pragma unroll 1
      for (int rep = 0; rep < REP_P3; ++rep)
      for (int m = b0 * NWAVES + wave; m < S_; m += nb * NWAVES) norm_row2<false, false>(XN + (size_t)m * 64, (size_t)S_ * 64, Y + (size_t)m * D_, SSP + (size_t)m * 64, 0.5f, KARG(4), nullptr, nullptr, nullptr, 0, RSTD + m, lane); }
    if (STOP_AFTER <= 3) return;
    CONV_DRAIN(CE_WIN);
    GRID_BAR();
#pragma unroll 1
    for (int rep = 0; rep < REP_P4; ++rep)
    { pg8::Gemm g{XN, WIN, S_, INW, D_}; pg8::StaticOrder S; S.init(S_, INW, G, bid); pg8::EpiProj E{PROJ, S_, ROPE, RSTD};
      pg8::gemm_phase<pg8::EpiProj, pg8::StaticOrder, PG8_ALIGNV, PG8_SP2V, true>(lds, g, S, E); }
    GRID_BAR();
    {
        float lam;
        { const float a = wave_sum(KARG(12)[lane] * KARG(13)[lane]), b = wave_sum(KARG(14)[lane] * KARG(15)[lane]); lam = __expf(a) - __expf(b) + 0.2f; }
        LAS char* alds = (LAS char*)lds;
        for (int it = bid; it < 256 * REP_P5; it += G) {
            const int h = it & 15, y = (it >> 4) & 15;
#if !defined(ATT_TEST) || ATT_TEST == 1
            for (int s = 0; s < 2; ++s) { const int qt = s ? y : 31 - y, q0 = 256 * qt, nt = 4 * (qt + 1);
                int tl = threadIdx.x; asm volatile("" : "+v"(tl)); const int r32 = tl & 31, hi = (tl >> 5) & 1;
                att::f32x16 o[4];
                att::attn_core<att::M_SOFT_B>(PROJ + ((size_t)(0 * 16 + h) * S_ + q0) * 128, 128, PROJ + ((size_t)(1 * 16 + h) * S_) * 128, PROJ + ((size_t)(2 * 16 + h) * S_) * 128, 128, q0, nt, alds, o, 0);
                int tsp = threadIdx.x; asm volatile("" : "+v"(tsp));
                f32x4* sp = (f32x4*)(SCR + (size_t)bid * (64 * 512) + tsp * 64);
#pragma unroll
                for (int d = 0; d < 4; ++d)
#pragma unroll
                    for (int k = 0; k < 4; ++k) sp[d * 4 + k] = (f32x4){o[d][4 * k], o[d][4 * k + 1], o[d][4 * k + 2], o[d][4 * k + 3]};
                att::attn_core<att::M_SOFT_A>(PROJ + ((size_t)(0 * 16 + h) * S_ + q0) * 128, 128, PROJ + ((size_t)(1 * 16 + h) * S_) * 128, PROJ + ((size_t)(2 * 16 + h) * S_) * 128, 128, q0, nt, alds, o, 0);
#pragma unroll
                for (int d = 0; d < 4; ++d)
#pragma unroll
                    for (int k = 0; k < 4; ++k) { const f32x4 v = sp[d * 4 + k];
#pragma unroll
                        for (int e = 0; e < 4; ++e) o[d][4 * k + e] -= lam * v[e]; }
                att::store_rows<true>(o, KARG(16), 0.8f, MERGED + ((size_t)(2 * h) * S_ + q0 + wave * 32) * 64, 64, (size_t)S_ * 64, alds);
            }
#endif
#if !defined(ATT_TEST) || ATT_TEST == 2
            for (int s = 0; s < 2; ++s) { const int qt = s ? y : 31 - y, q0 = 256 * qt, nt = 4 * (qt + 1);
                int tl = threadIdx.x; asm volatile("" : "+v"(tl)); const int r32 = tl & 31, hi = (tl >> 5) & 1;
                att::f32x16 o[4];
                att::attn_core<att::M_SB>(PROJ + ((size_t)(3 * 16 + h) * S_ + q0) * 128, 128, PROJ + ((size_t)(4 * 16 + h) * S_) * 128, PROJ + ((size_t)(5 * 16 + h) * S_) * 128, 128, q0, nt, alds, o, s);
                att::store_rows<true>(o, KARG(17), 1.0f, MERGED + ((size_t)(32 + 2 * h) * S_ + q0 + wave * 32) * 64, 64, (size_t)S_ * 64, alds);
            }
#endif
        }
    }
    CONV_DRAIN(CE_WOUT);
    GRID_BAR();
#pragma unroll 1
    for (int rep = 0; rep < REP_P6; ++rep)
    { pg8::Gemm g{MERGED, WOUT, S_, D_, D_}; pg8::StaticOrder S; S.init(S_, D_, G, bid); pg8::EpiBf16SS E{Y, D_, SSP, 1.0f};
      pg8::gemm_phase<pg8::EpiBf16SS, pg8::StaticOrder, PG8_ALIGNV, PG8_SP2V, true>(lds, g, S, E); }
    GRID_BAR();
    for (int m = gw; m < S_; m += NGW) norm_row2<false, false>(XN + (size_t)m * 64, (size_t)S_ * 64, Y + (size_t)m * D_, SSP + (size_t)m * 64, 1.0f, KARG(9), nullptr, nullptr, nullptr, 0, RSTD + m, lane);
    if (STOP_AFTER <= 7) return;
    CONV_DRAIN(CE_WQ);
    GRID_BAR();
    if (bid < (S_ / 256) * (XW / 256)) {
      { pg8::Gemm g{XN, WQ, S_, XW, D_}; pg8::StaticOrder S; S.init(S_, XW, G, bid); pg8::EpiBf16S E{XQ, XW, 0.08838834764831845f * pg8::LOG2E, RSTD};
        pg8::gemm_phase<pg8::EpiBf16S, pg8::StaticOrder, false, true, true>(lds, g, S, E); }
      CONV_RAISE(2);
    } else CONV_HELP(2);
    GRID_BAR();
    if (bid < 128) {
        const int r32 = lane & 31, hi = lane >> 5; LAS char* alds = (LAS char*)lds;
        for (int it = bid; it < 128; it += G) { const int h = it & 3, q0 = 256 * (it >> 2);
            att::f32x16 o[4];
            att::attn_core<att::M_DENSE>(XQ + (size_t)q0 * XW + h * 128, XW, KV + h * 128, KV + XW + h * 128, 2 * XW, 0, 4, alds, o, 0);
            att::store_rows<false>(o, nullptr, 1.0f, XO + ((size_t)(2 * h) * S_ + q0 + wave * 32) * 64, 64, (size_t)S_ * 64, alds); }
        if (bid + G >= 128) CONV_RAISE(3);
    } else CONV_HELP(3);
    CONV_DRAIN(CE_WO);
    GRID_BAR();
    { pg8::Gemm g{XO, WO, S_, D_, XW}; pg8::StaticOrder S; S.init(S_, D_, G, bid); pg8::EpiBf16SS E{Y, D_, SSP, 1.0f};
      pg8::gemm_phase<pg8::EpiBf16SS, pg8::StaticOrder, PG8_ALIGNV, PG8_SP2V, true>(lds, g, S, E); }
    GRID_BAR();
    for (int m = gw; m < S_; m += NGW) norm_row2<false, true>(XN + (size_t)m * 64, (size_t)S_ * 64, Y + (size_t)m * D_, SSP + (size_t)m * 64, 1.0f, KARG(19), nullptr, KARG(24), XN8 + (size_t)m * 128, (size_t)S_ * 128, nullptr, lane);
    if (STOP_AFTER <= 11) return;
    CONV_DRAIN(CE_WGU2);
    GRID_BAR();
    { pg8::Gemm g{(const bf16*)XN8, WGU2, S_, 2 * FF_, D_}; pg8::StaticOrder S; S.init(S_, 2 * FF_, G, bid); pg8::EpiSwiGLU E{HID, FF_, S_, 0.00390625f, CONV_FP8 >= 2, nullptr};
      pg8::gemm_phase<pg8::EpiSwiGLU, pg8::StaticOrder, PG8_ALIGNV, PG8_SP2V, true, CONV_FP8 != 0>(lds, g, S, E); }
    CONV_DRAIN(CE_ALL);
    GRID_BAR();
    { pg8::Gemm g{HID, WD2, S_, D_, FF_}; pg8::StaticOrder S; S.init(S_, D_, G, bid); pg8::EpiBf16SS E{Y, D_, SSP, CONV_FP8 >= 2 ? 0.00390625f : 1.0f};
      pg8::gemm_phase<pg8::EpiBf16SS, pg8::StaticOrder, PG8_ALIGNV, PG8_SP2V, true, (CONV_FP8 >= 2)>(lds, g, S, E); }
    GRID_BAR();
    for (int m = gw; m < S_; m += NGW) norm_row2<true, false>(XN + (size_t)m * 64, (size_t)S_ * 64, Y + (size_t)m * D_, SSP + (size_t)m * 64, 0.5f, KARG(25), out + (size_t)m * D_, nullptr, nullptr, 0, nullptr, lane);
}

extern "C" void kernel_launch(void* const* d_in, const int* in_sizes, int n_in, void* d_out, int out_size, void* d_ws, size_t ws_size, hipStream_t stream) {
    static int grid = 0;
    if (grid == 0) {
        if (n_in != 29 || in_sizes[0] != S_ * D_ || out_size != S_ * D_ || ws_size < WS_END) {
            fprintf(stderr, "kernel_launch: built for 29 inputs, x/out of %d floats, >= %zu bytes of workspace; got n_in %d, in0 %d, out %d, ws %zu; nothing launched\n", S_ * D_, (size_t)WS_END, n_in, n_in > 0 ? in_sizes[0] : -1, out_size, ws_size); grid = -1; return; }
        int dev = 0, cus = 0, per_cu = 0;
        if (hipGetDevice(&dev) != hipSuccess || hipDeviceGetAttribute(&cus, hipDeviceAttributeMultiprocessorCount, dev) != hipSuccess) { fprintf(stderr, "kernel_launch: device query failed\n"); grid = -1; return; }
        if (hipFuncSetAttribute((const void*)mega_fwd, hipFuncAttributeMaxDynamicSharedMemorySize, LDS_BYTES) != hipSuccess) { fprintf(stderr, "kernel_launch: hipFuncSetAttribute failed\n"); grid = -1; return; }
        if (hipOccupancyMaxActiveBlocksPerMultiprocessor(&per_cu, (const void*)mega_fwd, NWAVES * 64, LDS_BYTES) != hipSuccess || per_cu < 1) {
            fprintf(stderr, "kernel_launch: occupancy query reports %d workgroups per CU; nothing launched\n", per_cu); (void)hipGetLastError(); grid = -1; return; }
        grid = cus;
        fprintf(stderr, "kernel_launch: grid %d x %d threads, %d B LDS, occupancy query %d per CU, ws %zu\n", grid, NWAVES * 64, LDS_BYTES, per_cu, ws_size);
    }
    if (grid < 0) return;
    if (hipMemsetAsync((char*)d_ws + WS_CTL, 0, CTL_ZERO_BYTES, stream) != hipSuccess) { fprintf(stderr, "kernel_launch: hipMemsetAsync failed\n"); return; }
    Args a{};
    for (int i = 0; i < 29; ++i) a.in[i] = (const float*)d_in[i];
    a.pos = (const int*)d_in[2]; a.out = (float*)d_out; a.ws = (unsigned char*)d_ws;
    for (int i = 0; i < 8; ++i) a.inv_freq[i] = (float)pow(500000.0, -(double)(2 * i) / 16.0);
    hipLaunchKernelGGL(mega_fwd, dim3(grid), dim3(NWAVES * 64), LDS_BYTES, stream, a);
    const hipError_t le = hipPeekAtLastError();
    if (le != hipSuccess) fprintf(stderr, "kernel_launch: launch failed: %s\n", hipGetErrorName(le));
}
```

```cpp
#define ATT_VPRE 1
#include <hip/hip_runtime.h>
#include <cstdio>
#include <cstdint>
#include <cmath>
#ifndef PG8_WGM
#define PG8_WGM 8
#endif
namespace pg8 {
#define PG8_LAS __attribute__((address_space(3)))
typedef unsigned short bf16_t;
typedef short bf16x8 __attribute__((ext_vector_type(8)));
typedef float f32x4 __attribute__((ext_vector_type(4)));
typedef unsigned u32x4 __attribute__((ext_vector_type(4)));
constexpr int BM = 256, BK = 64, HALF = 128, HTB = HALF * BK * 2  , STAGE_BYTES = 8 * HTB, NXCD = 8, WGM = PG8_WGM;

__host__ __device__ __forceinline__ int lds_byte(int r, int c) { const int st = (r >> 4) * 2 + (c >> 5), rr = r & 15, cc = c & 31, ob = rr * 64 + cc * 2; return st * 1024 + (ob ^ (((ob >> 9) & 1) << 5)); }
__host__ __device__ __forceinline__ void stage_rc(int b, int& R, int& C) { const int st = b / 1024, sb = b % 1024, swz = sb ^ (((sb >> 9) & 1) << 5); R = (st >> 1) * 16 + swz / 64; C = (st & 1) * 32 + (swz % 64) / 2; }
__host__ __device__ __forceinline__ int perm32(int rho) { const int n = rho >> 4, i = rho & 15; return 8 * (i >> 2) + 4 * n + (i & 3); }

struct Unit { int pm, pn; };
struct Gemm { const bf16_t* A; const bf16_t* Bt; int M, N, K; };

struct StaticOrder {
    int nM, nN, nwg, G, c;
    __host__ __device__ void init(int M, int N, int G_, int c_) { nM = M / BM; nN = N / BM; nwg = nM * nN; G = G_; c = c_; }
    __host__ __device__ bool next(int i, Unit& u) const {
        const long L = (long)i * G + c; if (L >= nwg) return false;
        int wgid = (int)L; { const int q = nwg / NXCD, r = nwg % NXCD, xcd = wgid % NXCD, off = wgid / NXCD; wgid = (xcd < r ? xcd * (q + 1) : r * (q + 1) + (xcd - r) * q) + off; }
        const int nig = WGM * nN, gid = wgid / nig, fm = gid * WGM, gsz = (nM - fm) < WGM ? (nM - fm) : WGM;
        u.pm = fm + ((wgid % nig) % gsz); u.pn = (wgid % nig) / gsz; return true;
    }
    __device__ __forceinline__ void a_ready(const Unit&) const {}
    __device__ __forceinline__ void done(const Unit&) const {}
};
__device__ __forceinline__ unsigned cvt_pk_bf16(float lo, float hi) { unsigned r; asm volatile("v_cvt_pk_bf16_f32 %0, %1, %2" : "=v"(r) : "v"(lo), "v"(hi)); return r; }

constexpr float LOG2E = 1.4426950408889634f;

struct EpiF32 {
    static constexpr bool PERM = false, AFTER_DRAIN = false;
    float* C; int ldc;
    __device__ __forceinline__ void operator()(const f32x4 (&acc)[2][2][4][2], const Unit& u, int wr, int wc, int fr, int fq) const {
        const int row0 = u.pm * BM + wr * 64 + fr, col0 = u.pn * BM + wc * 32 + 4 * fq;
#pragma unroll
        for (int ai = 0; ai < 2; ++ai)
#pragma unroll
            for (int m = 0; m < 4; ++m) { float* rowp = C + (size_t)(row0 + ai * HALF + m * 16) * ldc + col0;
#pragma unroll
                for (int bj = 0; bj < 2; ++bj)
#pragma unroll
                    for (int n = 0; n < 2; ++n) *(f32x4*)(rowp + bj * HALF + n * 16) = acc[ai][bj][m][n]; }
    }
};
struct EpiBf16S {
    static constexpr bool PERM = true, AFTER_DRAIN = false;
    bf16_t* O; int ldc; float sc; const float* rs;
    __device__ __forceinline__ void operator()(const f32x4 (&acc)[2][2][4][2], const Unit& u, int wr, int wc, int fr, int fq) const {
        const int row0 = u.pm * BM + wr * 64 + fr, col0 = u.pn * BM + wc * 32 + 8 * fq;
#pragma unroll
        for (int ai = 0; ai < 2; ++ai)
#pragma unroll
            for (int m = 0; m < 4; ++m) { bf16_t* rowp = O + (size_t)(row0 + ai * HALF + m * 16) * ldc + col0;
                const float scr = rs ? sc * rs[row0 + ai * HALF + m * 16] : sc;
#pragma unroll
                for (int bj = 0; bj < 2; ++bj) { const f32x4 v0 = acc[ai][bj][m][0] * scr, v1 = acc[ai][bj][m][1] * scr;
                    u32x4 w; w.x = cvt_pk_bf16(v0[0], v0[1]); w.y = cvt_pk_bf16(v0[2], v0[3]); w.z = cvt_pk_bf16(v1[0], v1[1]); w.w = cvt_pk_bf16(v1[2], v1[3]);
                    *(u32x4*)(rowp + bj * HALF) = w; } }
    }
};
struct EpiBf16SS {
    static constexpr bool PERM = true, AFTER_DRAIN = false;
    bf16_t* O; int ldc; float* SSP; float sc;
    __device__ __forceinline__ void operator()(const f32x4 (&acc)[2][2][4][2], const Unit& u, int wr, int wc, int fr, int fq) const {
        const int row0 = u.pm * BM + wr * 64 + fr, col0 = u.pn * BM + wc * 32 + 8 * fq;
#pragma unroll
        for (int ai = 0; ai < 2; ++ai)
#pragma unroll
            for (int m = 0; m < 4; ++m) { const int row = row0 + ai * HALF + m * 16; bf16_t* rowp = O + (size_t)row * ldc + col0; float ss = 0.f;
#pragma unroll
                for (int bj = 0; bj < 2; ++bj) { const f32x4 v0 = acc[ai][bj][m][0] * sc, v1 = acc[ai][bj][m][1] * sc;
                    ss += ((v0[0] * v0[0] + v0[1] * v0[1]) + (v0[2] * v0[2] + v0[3] * v0[3])) + ((v1[0] * v1[0] + v1[1] * v1[1]) + (v1[2] * v1[2] + v1[3] * v1[3]));
                    u32x4 w; w.x = cvt_pk_bf16(v0[0], v0[1]); w.y = cvt_pk_bf16(v0[2], v0[3]); w.z = cvt_pk_bf16(v1[0], v1[1]); w.w = cvt_pk_bf16(v1[2], v1[3]);
                    *(u32x4*)(rowp + bj * HALF) = w; }
                ss += __shfl_xor(ss, 16); ss += __shfl_xor(ss, 32);
                if (fq == 0) SSP[(size_t)row * 64 + u.pn * 4 + wc] = ss; }
    }
};
__device__ __forceinline__ float silu_mul(float g, float u) { const float s = __builtin_amdgcn_exp2f(-g * LOG2E); return g * __builtin_amdgcn_rcpf(1.0f + s) * u; }
struct EpiSwiGLU {
    static constexpr bool PERM = true, AFTER_DRAIN = false;
    bf16_t* O; int ldc; int blkM; float sc; int fp8out; const float* rs;
    __device__ __forceinline__ void operator()(const f32x4 (&acc)[2][2][4][2], const Unit& u, int wr, int wc, int fr, int fq) const {
        const int row0 = u.pm * BM + wr * 64 + fr, col0 = u.pn * HALF + wc * 32 + 8 * fq;
        const size_t rpitch = blkM ? (size_t)BK : (size_t)ldc, cbase = blkM ? (size_t)(col0 >> 6) * blkM * BK + (col0 & 63) : (size_t)col0;
#pragma unroll
        for (int ai = 0; ai < 2; ++ai)
#pragma unroll
            for (int m = 0; m < 4; ++m) { bf16_t* rowp = O + (size_t)(row0 + ai * HALF + m * 16) * rpitch + cbase;
                const float scr = rs ? sc * rs[row0 + ai * HALF + m * 16] : sc;
                const f32x4 g0 = acc[ai][0][m][0] * scr, g1 = acc[ai][0][m][1] * scr, u0 = acc[ai][1][m][0] * scr, u1 = acc[ai][1][m][1] * scr;
                if (fp8out) { typedef unsigned u32x2_ __attribute__((ext_vector_type(2))); u32x2_ w8;
                    int t0 = __builtin_amdgcn_cvt_pk_fp8_f32(silu_mul(g0[0], u0[0]), silu_mul(g0[1], u0[1]), 0, false); t0 = __builtin_amdgcn_cvt_pk_fp8_f32(silu_mul(g0[2], u0[2]), silu_mul(g0[3], u0[3]), t0, true);
                    int t1 = __builtin_amdgcn_cvt_pk_fp8_f32(silu_mul(g1[0], u1[0]), silu_mul(g1[1], u1[1]), 0, false); t1 = __builtin_amdgcn_cvt_pk_fp8_f32(silu_mul(g1[2], u1[2]), silu_mul(g1[3], u1[3]), t1, true);
                    w8.x = (unsigned)t0; w8.y = (unsigned)t1;
                    *(u32x2_*)((unsigned char*)O + ((size_t)u.pn * blkM + (row0 + ai * HALF + m * 16)) * 128 + wc * 32 + 8 * fq) = w8; }
                else {
                u32x4 w; w.x = cvt_pk_bf16(silu_mul(g0[0], u0[0]), silu_mul(g0[1], u0[1])); w.y = cvt_pk_bf16(silu_mul(g0[2], u0[2]), silu_mul(g0[3], u0[3]));
                w.z = cvt_pk_bf16(silu_mul(g1[0], u1[0]), silu_mul(g1[1], u1[1])); w.w = cvt_pk_bf16(silu_mul(g1[2], u1[2]), silu_mul(g1[3], u1[3]));
                *(u32x4*)rowp = w; } }
    }
};
struct EpiProj {
    static constexpr bool PERM = true, AFTER_DRAIN = false;
    bf16_t* O; int ldc; const float* rope; const float* rs;
    __device__ __forceinline__ void operator()(const f32x4 (&acc)[2][2][4][2], const Unit& u, int wr, int wc, int fr, int fq) const {
        const int region = u.pn >> 3;
        const float sc = region == 0 ? 0.125f * LOG2E : (region == 3 ? 0.08838834764831845f * LOG2E : 1.0f);
        const bool rope_wave = (region < 2) && ((wc & 1) == 0);
        const int row0 = u.pm * BM + wr * 64 + fr;
        const float sgn = fq == 0 ? -1.0f : 1.0f;
        bf16_t* hp = O + ((size_t)(region * 16 + (u.pn & 7) * 2) * ldc) * 128 + wc * 32 + 8 * fq;
#pragma unroll
        for (int ai = 0; ai < 2; ++ai)
#pragma unroll
            for (int m = 0; m < 4; ++m) { const int row = row0 + ai * HALF + m * 16; bf16_t* rowp = hp + (size_t)row * 128;
                const float scr = sc * rs[row];
                f32x4 c0 = {1.f, 1.f, 1.f, 1.f}, c1 = c0, s0 = {0.f, 0.f, 0.f, 0.f}, s1 = s0;
                if (rope_wave && fq < 2) { const f32x4* rp = (const f32x4*)(rope + (size_t)row * 16); c0 = rp[0]; c1 = rp[1]; s0 = rp[2] * sgn; s1 = rp[3] * sgn; }
#pragma unroll
                for (int bj = 0; bj < 2; ++bj) { f32x4 v0 = acc[ai][bj][m][0], v1 = acc[ai][bj][m][1];
                    if (rope_wave) { f32x4 o0, o1;
#pragma unroll
                        for (int j = 0; j < 4; ++j) { o0[j] = __shfl_xor(v0[j], 16); o1[j] = __shfl_xor(v1[j], 16); }
                        v0 = v0 * c0 + o0 * s0; v1 = v1 * c1 + o1 * s1; }
                    v0 = v0 * scr; v1 = v1 * scr;
                    u32x4 w; w.x = cvt_pk_bf16(v0[0], v0[1]); w.y = cvt_pk_bf16(v0[2], v0[3]); w.z = cvt_pk_bf16(v1[0], v1[1]); w.w = cvt_pk_bf16(v1[2], v1[3]);
                    *(u32x4*)(rowp + (size_t)bj * ldc * 128) = w; }
                asm volatile("" ::: "memory"); }
    }
};
struct RowOrder {
    int nN, G, c;
    __device__ bool next(int i, Unit& u) const { const int L = i * G + c; if (L >= nN) return false; u.pm = 0; u.pn = L; return true; }
    __device__ __forceinline__ void a_ready(const Unit&) const {}
    __device__ __forceinline__ void done(const Unit&) const {}
};
template <class Epi, class Sched, bool ALIGN_EPI = false, bool SP2 = false, bool BLK = false, bool FP8 = false>
__device__ __forceinline__ void gemm_phase(PG8_LAS unsigned char* lds, const Gemm g, const Sched& S, const Epi& E) {
    int tid_ = threadIdx.x; asm volatile("" : "+v"(tid_));
    const int tid = tid_, wid = __builtin_amdgcn_readfirstlane(tid >> 6), lane = tid & 63, wr = wid >> 2, wc = wid & 3, fr = lane & 15, fq = lane >> 4;
    const int K = g.K, nt = K / (FP8 ? 2 * BK : BK);
    const int pitch = BLK ? BK : K;
    unsigned voffA[2], voffB[2];
#pragma unroll
    for (int i = 0; i < 2; ++i) { int R, C; stage_rc(tid * 16 + i * 8192, R, C); const int Rb = Epi::PERM ? ((R & ~31) + perm32(R & 31)) : R;
        voffA[i] = (unsigned)(R * pitch + C) * 2u; voffB[i] = (unsigned)(Rb * pitch + C) * 2u; }
    const size_t kstepA = BLK ? (size_t)g.M * BK * 2 : (size_t)(BK * 2), kstepB = BLK ? (size_t)g.N * BK * 2 : (size_t)(BK * 2);
    const size_t hstep = (size_t)HALF * pitch * 2;
    const size_t tstep = 2 * hstep;
    const unsigned ldsw = (unsigned)wid * 1024u;
    const int aoff = lds_byte(wr * 64 + fr, fq * 8), boff = lds_byte(wc * 32 + fr, fq * 8);
#define PG8_SA(b, h) (((b) * 2 + (h)) * HTB)
#define PG8_SB(b, h) ((4 + (b) * 2 + (h)) * HTB)
#define PG8_STAGE(bufoff, gbase, voff) do { _Pragma("unroll") for (int _i = 0; _i < 2; ++_i) \
        __builtin_amdgcn_global_load_lds((const unsigned*)((const char*)(gbase) + (voff)[_i]), (PG8_LAS unsigned*)(lds + (bufoff) + ldsw + _i * 8192), 16, 0, 0); } while (0)
#define PG8_LDA(dst, b, h) do { if constexpr (FP8) { _Pragma("unroll") for (int m = 0; m < 4; ++m) { const i32x4_ lo_ = *(const PG8_LAS i32x4_*)(lds + PG8_SA(b, h) + aoff + m * 2048), hi_ = *(const PG8_LAS i32x4_*)(lds + PG8_SA(b, h) + aoff + m * 2048 + 1024); \
            dst##8[m] = __builtin_shufflevector(lo_, hi_, 0, 1, 2, 3, 4, 5, 6, 7); } } \
        else { _Pragma("unroll") for (int m = 0; m < 4; ++m) _Pragma("unroll") for (int k = 0; k < 2; ++k) dst[m][k] = *(const PG8_LAS bf16x8*)(lds + PG8_SA(b, h) + aoff + m * 2048 + k * 1024); } } while (0)
#define PG8_LDB(dst, b, h) do { if constexpr (FP8) { _Pragma("unroll") for (int n = 0; n < 2; ++n) { const i32x4_ lo_ = *(const PG8_LAS i32x4_*)(lds + PG8_SB(b, h) + boff + n * 2048), hi_ = *(const PG8_LAS i32x4_*)(lds + PG8_SB(b, h) + boff + n * 2048 + 1024); \
            dst##8[n] = __builtin_shufflevector(lo_, hi_, 0, 1, 2, 3, 4, 5, 6, 7); } } \
        else { _Pragma("unroll") for (int n = 0; n < 2; ++n) _Pragma("unroll") for (int k = 0; k < 2; ++k) dst[n][k] = *(const PG8_LAS bf16x8*)(lds + PG8_SB(b, h) + boff + n * 2048 + k * 1024); } } while (0)
#define PG8_MMA(ai, bj, At, Bt) do { __builtin_amdgcn_s_setprio(1); _Pragma("unroll") for (int m = 0; m < 4; ++m) _Pragma("unroll") for (int n = 0; n < 2; ++n) { \
        if constexpr (FP8) asm volatile("v_mfma_scale_f32_16x16x128_f8f6f4 %0, %1, %2, %0, %3, %3 op_sel_hi:[0,0,0]" : "+v"(acc[ai][bj][m][n]) : "v"(Bt##8[n]), "v"(At##8[m]), "v"(0x7f7f7f7f)); \
        else { _Pragma("unroll") for (int k = 0; k < 2; ++k) acc[ai][bj][m][n] = __builtin_amdgcn_mfma_f32_16x16x32_bf16(Bt[n][k], At[m][k], acc[ai][bj][m][n], 0, 0, 0); } } \
        __builtin_amdgcn_s_setprio(0); } while (0)
#define PG8_WAIT_V(n) asm volatile("s_waitcnt vmcnt(" #n ")" ::: "memory")
#define PG8_WAIT_L(n) asm volatile("s_waitcnt lgkmcnt(" #n ")" ::: "memory")
#define PG8_BAR __builtin_amdgcn_s_barrier()
#define PG8_SCHED __builtin_amdgcn_sched_barrier(0)
    Unit cur, nxt; int ui = 0;
    if (!S.next(0, cur)) return;
    f32x4 acc[2][2][4][2];
#pragma unroll
    for (int a = 0; a < 2; ++a)
#pragma unroll
        for (int b = 0; b < 2; ++b)
#pragma unroll
            for (int m = 0; m < 4; ++m)
#pragma unroll
                for (int n = 0; n < 2; ++n) acc[a][b][m][n] = (f32x4){0.f, 0.f, 0.f, 0.f};
    typedef int i32x4_ __attribute__((ext_vector_type(4))); typedef int i32x8_ __attribute__((ext_vector_type(8)));
    bf16x8 At[4][2], B0[2][2], B1[2][2]; i32x8_ At8[4], B08[2], B18[2];
    const char* cA = (const char*)g.A + (size_t)cur.pm * tstep; const char* cB = (const char*)g.Bt + (size_t)cur.pn * tstep;
    S.a_ready(cur);
    if constexpr (SP2) {
        PG8_STAGE(PG8_SB(0, 0), cB, voffB); PG8_STAGE(PG8_SB(0, 1), cB + hstep, voffB); PG8_STAGE(PG8_SA(0, 0), cA, voffA); PG8_STAGE(PG8_SA(0, 1), cA + hstep, voffA);
        if (wr == 1) PG8_BAR;
        PG8_WAIT_V(2); PG8_BAR;
        PG8_STAGE(PG8_SB(1, 0), cB + kstepB, voffB); PG8_STAGE(PG8_SA(1, 0), cA + kstepA, voffA); PG8_STAGE(PG8_SB(1, 1), cB + hstep + kstepB, voffB);
        PG8_WAIT_V(6); PG8_BAR;
    } else {
        PG8_STAGE(PG8_SB(0, 0), cB, voffB); PG8_STAGE(PG8_SA(0, 0), cA, voffA); PG8_STAGE(PG8_SB(0, 1), cB + hstep, voffB); PG8_STAGE(PG8_SA(0, 1), cA + hstep, voffA);
        if (wr == 1) PG8_BAR;
        PG8_WAIT_V(4); PG8_BAR;
        PG8_STAGE(PG8_SB(1, 0), cB + kstepB, voffB); PG8_STAGE(PG8_SA(1, 0), cA + kstepA, voffA); PG8_STAGE(PG8_SB(1, 1), cB + hstep + kstepB, voffB);
        PG8_WAIT_V(6); PG8_BAR;
    }
    for (;;) {
        const bool has_next = S.next(ui + 1, nxt);
        const char* nA = has_next ? (const char*)g.A + (size_t)nxt.pm * tstep : cA; const char* nB = has_next ? (const char*)g.Bt + (size_t)nxt.pn * tstep : cB;
        for (int t = 0; t < nt; t += 2) {
            const bool last = (t == nt - 2);
            const char* a1 = cA + (size_t)(t + 1) * kstepA;
            const char* a2 = last ? nA : cA + (size_t)(t + 2) * kstepA; const char* b2 = last ? nB : cB + (size_t)(t + 2) * kstepB;
            const char* a3 = a2 + kstepA; const char* b3 = b2 + kstepB;
            if (last && has_next) S.a_ready(nxt);
            if constexpr (SP2) {
            PG8_LDB(B0, 0, 0); PG8_LDB(B1, 0, 1); PG8_SCHED; PG8_LDA(At, 0, 0); PG8_STAGE(PG8_SA(1, 1), a1 + hstep, voffA);
            PG8_WAIT_V(8); PG8_WAIT_L(0); PG8_BAR; PG8_MMA(0, 0, At, B0); PG8_MMA(0, 1, At, B1); PG8_BAR; PG8_SCHED;
            PG8_LDA(At, 0, 1); PG8_STAGE(PG8_SB(0, 0), b2, voffB); PG8_STAGE(PG8_SB(0, 1), b2 + hstep, voffB); PG8_STAGE(PG8_SA(0, 0), a2, voffA);
            PG8_WAIT_V(8); PG8_WAIT_L(0); PG8_BAR; PG8_MMA(1, 0, At, B0); PG8_MMA(1, 1, At, B1); PG8_BAR; PG8_SCHED;
            PG8_LDB(B0, 1, 0); PG8_LDB(B1, 1, 1); PG8_SCHED; PG8_LDA(At, 1, 0); PG8_STAGE(PG8_SA(0, 1), a2 + hstep, voffA);
            PG8_WAIT_V(8); PG8_WAIT_L(0); PG8_BAR; PG8_MMA(0, 0, At, B0); PG8_MMA(0, 1, At, B1); PG8_BAR; PG8_SCHED;
            PG8_LDA(At, 1, 1); PG8_STAGE(PG8_SB(1, 0), b3, voffB); PG8_STAGE(PG8_SB(1, 1), b3 + hstep, voffB); PG8_STAGE(PG8_SA(1, 0), a3, voffA);
            PG8_WAIT_V(8); PG8_WAIT_L(0); PG8_BAR; PG8_MMA(1, 0, At, B0); PG8_MMA(1, 1, At, B1); PG8_BAR; PG8_SCHED;
            } else {
            PG8_LDB(B0, 0, 0); PG8_SCHED; PG8_LDA(At, 0, 0); PG8_STAGE(PG8_SA(1, 1), a1 + hstep, voffA);
            PG8_WAIT_L(8); PG8_BAR; PG8_WAIT_L(0); PG8_MMA(0, 0, At, B0); PG8_BAR; PG8_SCHED;
            PG8_LDB(B1, 0, 1); PG8_STAGE(PG8_SB(0, 0), b2, voffB);
            PG8_BAR; PG8_WAIT_L(0); PG8_MMA(0, 1, At, B1); PG8_BAR;
            PG8_LDA(At, 0, 1); PG8_STAGE(PG8_SA(0, 0), a2, voffA);
            PG8_BAR; PG8_WAIT_L(0); PG8_MMA(1, 0, At, B0); PG8_BAR; PG8_SCHED;
            PG8_STAGE(PG8_SB(0, 1), b2 + hstep, voffB);
            PG8_WAIT_V(6); PG8_BAR; PG8_MMA(1, 1, At, B1); PG8_BAR;
            PG8_LDB(B0, 1, 0); PG8_SCHED; PG8_LDA(At, 1, 0); PG8_STAGE(PG8_SA(0, 1), a2 + hstep, voffA);
            PG8_WAIT_L(8); PG8_BAR; PG8_WAIT_L(0); PG8_MMA(0, 0, At, B0); PG8_BAR; PG8_SCHED;
            PG8_LDB(B1, 1, 1); PG8_STAGE(PG8_SB(1, 0), b3, voffB);
            PG8_BAR; PG8_WAIT_L(0); PG8_MMA(0, 1, At, B1); PG8_BAR;
            PG8_LDA(At, 1, 1); PG8_STAGE(PG8_SA(1, 0), a3, voffA);
            PG8_BAR; PG8_WAIT_L(0); PG8_MMA(1, 0, At, B0); PG8_BAR; PG8_SCHED;
            PG8_STAGE(PG8_SB(1, 1), b3 + hstep, voffB);
            PG8_WAIT_V(6); PG8_BAR; PG8_MMA(1, 1, At, B1); PG8_BAR;
            }
        }
        if constexpr (ALIGN_EPI) { if (wr == 0) PG8_BAR; }
        if constexpr (FP8) asm volatile("s_nop 15\n\ts_nop 15" ::: "memory");
        if constexpr (!Epi::AFTER_DRAIN) { int tz = tid; asm volatile("" : "+v"(tz));
            E(acc, cur, wr, wc, tz & 15, (tz & 63) >> 4); S.done(cur); }
        if (!has_next) break;
#pragma unroll
        for (int a = 0; a < 2; ++a)
#pragma unroll
            for (int b = 0; b < 2; ++b)
#pragma unroll
                for (int m = 0; m < 4; ++m)
#pragma unroll
                    for (int n = 0; n < 2; ++n) acc[a][b][m][n] = (f32x4){0.f, 0.f, 0.f, 0.f};
        cur = nxt; cA = nA; cB = nB; ++ui;
        if constexpr (ALIGN_EPI) { if (wr == 1) PG8_BAR; }
    }
    PG8_WAIT_V(0);
    if constexpr (!ALIGN_EPI) { if (wr == 0) PG8_BAR; }
    PG8_BAR;
    if constexpr (Epi::AFTER_DRAIN) { E.fused(acc, cur, wr, wc, fr, fq, lds, wid, lane); S.done(cur); }
#undef PG8_SA
#undef PG8_SB
#undef PG8_STAGE
#undef PG8_LDA
#undef PG8_LDB
#undef PG8_MMA
#undef PG8_WAIT_V
#undef PG8_WAIT_L
#undef PG8_BAR
#undef PG8_SCHED
}
}

namespace att {
#define ATT_LAS __attribute__((address_space(3)))
typedef unsigned short bf16_t;
typedef short bf16x8 __attribute__((ext_vector_type(8)));
typedef short s16x4 __attribute__((ext_vector_type(4)));
typedef float f32x16 __attribute__((ext_vector_type(16)));
typedef float f32x4 __attribute__((ext_vector_type(4)));
typedef unsigned u32x4 __attribute__((ext_vector_type(4)));
constexpr int SHM_K = 64 * 128 * 2, SHM_V = 64 * 128 * 2;
constexpr int NBUF = 4, SCR_OFF = 131072 + 1024;
constexpr int LDS_BYTES = SCR_OFF + 8 * 64 * 4 + 64;
constexpr float SB_EPS = 9.094947017729282e-13f;
#define ATT_KSWZ(row, colB) ((row) * 256 + ((colB) ^ (((row) & 7) << 4)))
#define ATT_SBAR() __builtin_amdgcn_sched_barrier(0)
__device__ __forceinline__ int crow(int r, int hi) { return (r & 3) + 8 * (r >> 2) + 4 * hi; }
__device__ __forceinline__ unsigned cvtpk(float lo, float hi) { unsigned r; asm volatile("v_cvt_pk_bf16_f32 %0, %1, %2" : "=v"(r) : "v"(lo), "v"(hi)); return r; }
__device__ __forceinline__ int v_st(int k, int c) { const int kk = (k & ~0xC) | ((k & 4) << 1) | ((k & 8) >> 1); return ((kk >> 3) * 4 + (c >> 5)) * 512 + ((kk & 7) * 32 + (c & 31)) * 2; }
__device__ __forceinline__ int v_rd_base(int lane) { return ((lane & 3) << 3) | (((lane >> 2) & 3) << 6) | (((lane >> 4) & 1) << 5) | (((lane >> 5) & 1) << 8); }
constexpr int v_rd_off(int d0, int ks, int half) { return d0 * 512 + ks * 4096 + half * 2048; }
template <int OFF> __device__ __forceinline__ s16x4 tr_read(int vb) { s16x4 r; asm volatile("ds_read_b64_tr_b16 %0, %1 offset:%2" : "=&v"(r) : "v"(vb), "i"(OFF) : "memory"); return r; }
template <int D0> __device__ __forceinline__ void pv_one(f32x16& od, int vb, bf16x8 pa0, bf16x8 pa1, bf16x8 pa2, bf16x8 pa3) {
  const s16x4 l0 = tr_read<v_rd_off(D0, 0, 0)>(vb), h0 = tr_read<v_rd_off(D0, 0, 1)>(vb), l1 = tr_read<v_rd_off(D0, 1, 0)>(vb), h1 = tr_read<v_rd_off(D0, 1, 1)>(vb);
  const s16x4 l2 = tr_read<v_rd_off(D0, 2, 0)>(vb), h2 = tr_read<v_rd_off(D0, 2, 1)>(vb), l3 = tr_read<v_rd_off(D0, 3, 0)>(vb), h3 = tr_read<v_rd_off(D0, 3, 1)>(vb);
  asm volatile("s_waitcnt lgkmcnt(0)" ::: "memory"); ATT_SBAR();
#define ATT_PK(L, H) (bf16x8){L[0], L[1], L[2], L[3], H[0], H[1], H[2], H[3]}
  od = __builtin_amdgcn_mfma_f32_32x32x16_bf16(pa0, ATT_PK(l0, h0), od, 0, 0, 0);
  od = __builtin_amdgcn_mfma_f32_32x32x16_bf16(pa1, ATT_PK(l1, h1), od, 0, 0, 0);
  od = __builtin_amdgcn_mfma_f32_32x32x16_bf16(pa2, ATT_PK(l2, h2), od, 0, 0, 0);
  od = __builtin_amdgcn_mfma_f32_32x32x16_bf16(pa3, ATT_PK(l3, h3), od, 0, 0, 0);
#undef ATT_PK
}
struct VFrag { s16x4 l0, h0, l1, h1, l2, h2, l3, h3; };
template <int D0> __device__ __forceinline__ void v_read8(VFrag& f, int vb) {
  f.l0 = tr_read<v_rd_off(D0, 0, 0)>(vb); f.h0 = tr_read<v_rd_off(D0, 0, 1)>(vb); f.l1 = tr_read<v_rd_off(D0, 1, 0)>(vb); f.h1 = tr_read<v_rd_off(D0, 1, 1)>(vb);
  f.l2 = tr_read<v_rd_off(D0, 2, 0)>(vb); f.h2 = tr_read<v_rd_off(D0, 2, 1)>(vb); f.l3 = tr_read<v_rd_off(D0, 3, 0)>(vb); f.h3 = tr_read<v_rd_off(D0, 3, 1)>(vb);
}
__device__ __forceinline__ void pv_mma(f32x16& od, const VFrag& f, bf16x8 pa0, bf16x8 pa1, bf16x8 pa2, bf16x8 pa3) {
#define ATT_PK(L, H) (bf16x8){L[0], L[1], L[2], L[3], H[0], H[1], H[2], H[3]}
  od = __builtin_amdgcn_mfma_f32_32x32x16_bf16(pa0, ATT_PK(f.l0, f.h0), od, 0, 0, 0);
  od = __builtin_amdgcn_mfma_f32_32x32x16_bf16(pa1, ATT_PK(f.l1, f.h1), od, 0, 0, 0);
  od = __builtin_amdgcn_mfma_f32_32x32x16_bf16(pa2, ATT_PK(f.l2, f.h2), od, 0, 0, 0);
  od = __builtin_amdgcn_mfma_f32_32x32x16_bf16(pa3, ATT_PK(f.l3, f.h3), od, 0, 0, 0);
#undef ATT_PK
}
__device__ __forceinline__ void pv_d0(f32x16 (&o)[4], int vb, bf16x8 pa0, bf16x8 pa1, bf16x8 pa2, bf16x8 pa3) {
  VFrag fa, fb;
  v_read8<0>(fa, vb); v_read8<1>(fb, vb);
  asm volatile("s_waitcnt lgkmcnt(8)" ::: "memory"); ATT_SBAR();
  pv_mma(o[0], fa, pa0, pa1, pa2, pa3); ATT_SBAR();
  v_read8<2>(fa, vb);
  asm volatile("s_waitcnt lgkmcnt(8)" ::: "memory"); ATT_SBAR();
  pv_mma(o[1], fb, pa0, pa1, pa2, pa3); ATT_SBAR();
  v_read8<3>(fb, vb);
  asm volatile("s_waitcnt lgkmcnt(8)" ::: "memory"); ATT_SBAR();
  pv_mma(o[2], fa, pa0, pa1, pa2, pa3); ATT_SBAR();
  asm volatile("s_waitcnt lgkmcnt(0)" ::: "memory"); ATT_SBAR();
  pv_mma(o[3], fb, pa0, pa1, pa2, pa3);
}
template <int OFF> __device__ __forceinline__ bf16x8 lds_read16(int a) { bf16x8 r; asm volatile("ds_read_b128 %0, %1 offset:%2" : "=&v"(r) : "v"(a), "i"(OFF) : "memory"); return r; }
template <int D0> __device__ __forceinline__ void qkt4(f32x16& p0, f32x16& p1, int kbase, const bf16x8 (&qr)[8], int r32, int hi) {
  bf16x8 kf[8];
#pragma unroll
  for (int i = 0; i < 4; ++i) { const int cb = ((D0 + i) * 16 + hi * 8) * 2, a = kbase + ATT_KSWZ(r32, cb); kf[2 * i] = lds_read16<0>(a); kf[2 * i + 1] = lds_read16<32 * 256>(a); }
  asm volatile("s_waitcnt lgkmcnt(4)" ::: "memory"); ATT_SBAR();
#pragma unroll
  for (int i = 0; i < 2; ++i) { p0 = __builtin_amdgcn_mfma_f32_32x32x16_bf16(kf[2 * i], qr[D0 + i], p0, 0, 0, 0); p1 = __builtin_amdgcn_mfma_f32_32x32x16_bf16(kf[2 * i + 1], qr[D0 + i], p1, 0, 0, 0); }
  ATT_SBAR(); asm volatile("s_waitcnt lgkmcnt(0)" ::: "memory"); ATT_SBAR();
#pragma unroll
  for (int i = 2; i < 4; ++i) { p0 = __builtin_amdgcn_mfma_f32_32x32x16_bf16(kf[2 * i], qr[D0 + i], p0, 0, 0, 0); p1 = __builtin_amdgcn_mfma_f32_32x32x16_bf16(kf[2 * i + 1], qr[D0 + i], p1, 0, 0, 0); }
}
template <int DLO, int DHI> __device__ __forceinline__ void qkt(f32x16& p0, f32x16& p1, const ATT_LAS char* Ks, const bf16x8 (&qr)[8], int r32, int hi) {
#pragma unroll
  for (int r = 0; r < 16; ++r) { p0[r] = 0.f; p1[r] = 0.f; }
  const int kbase = (int)(unsigned)(uintptr_t)Ks;
  qkt4<DLO>(p0, p1, kbase, qr, r32, hi);
  if (DHI - DLO == 8) qkt4<DLO + 4>(p0, p1, kbase, qr, r32, hi);
}
__device__ __forceinline__ void pack_p(const f32x16& p0, const f32x16& p1, bf16x8& pa0, bf16x8& pa1, bf16x8& pa2, bf16x8& pa3) {
#define ATT_PK4(P, BASE, OUT) do { unsigned a0 = cvtpk(P[BASE + 0], P[BASE + 1]), a1 = cvtpk(P[BASE + 2], P[BASE + 3]);   \
    unsigned b0 = cvtpk(P[BASE + 4], P[BASE + 5]), b1 = cvtpk(P[BASE + 6], P[BASE + 7]);                              \
    auto r0 = __builtin_amdgcn_permlane32_swap(a0, b0, false, false); auto r1 = __builtin_amdgcn_permlane32_swap(a1, b1, false, false); \
    u32x4 w = {r0[0], r1[0], r0[1], r1[1]}; OUT = __builtin_bit_cast(bf16x8, w); } while (0)
  ATT_PK4(p0, 0, pa0); ATT_PK4(p0, 8, pa1); ATT_PK4(p1, 0, pa2); ATT_PK4(p1, 8, pa3);
#undef ATT_PK4
}

__device__ __forceinline__ void pv_pre(VFrag& fa, VFrag& fb, int vb) { v_read8<0>(fa, vb); v_read8<1>(fb, vb); }
__device__ __forceinline__ void pv_post(f32x16 (&o)[4], VFrag& fa, VFrag& fb, int vb, bf16x8 pa0, bf16x8 pa1, bf16x8 pa2, bf16x8 pa3) {
  asm volatile("s_waitcnt lgkmcnt(0)" ::: "memory"); ATT_SBAR();
  pv_mma(o[0], fa, pa0, pa1, pa2, pa3); ATT_SBAR();
  v_read8<2>(fa, vb); ATT_SBAR();
  pv_mma(o[1], fb, pa0, pa1, pa2, pa3); ATT_SBAR();
  v_read8<3>(fb, vb);
  asm volatile("s_waitcnt lgkmcnt(8)" ::: "memory"); ATT_SBAR();
  pv_mma(o[2], fa, pa0, pa1, pa2, pa3); ATT_SBAR();
  asm volatile("s_waitcnt lgkmcnt(0)" ::: "memory"); ATT_SBAR();
  pv_mma(o[3], fb, pa0, pa1, pa2, pa3);
}

enum { M_SOFT_A = 0, M_SOFT_B = 1, M_SB = 2, M_DENSE = 3 };
template <int MODE>
__device__ __forceinline__ void attn_core(const bf16_t* __restrict__ Q0, int ldq, const bf16_t* __restrict__ Kb, const bf16_t* __restrict__ Vb, int ldk,
                                          int qpos0, int nt, ATT_LAS char* lds, f32x16 (&o)[4], int par) {
  constexpr bool SOFT = (MODE != M_SB), CAUSAL = (MODE == M_SOFT_A || MODE == M_SOFT_B), STRICT = (MODE == M_SB);
  constexpr int DLO = (MODE == M_SOFT_B) ? 4 : 0, DHI = (MODE == M_SOFT_A) ? 4 : 8;
  int tid_ = threadIdx.x; asm volatile("" : "+v"(tid_));
  const int tid = tid_, wid = __builtin_amdgcn_readfirstlane(tid >> 6), lane = tid & 63, r32 = lane & 31, hi = lane >> 5;
  ATT_LAS char* V_lds = lds; ATT_LAS char* K_lds = lds + NBUF * SHM_V;
  ATT_LAS float* wsf = (ATT_LAS float*)(lds + SCR_OFF) + wid * 64; ATT_LAS float* li_l = wsf; ATT_LAS float* al_l = wsf + 32;
#pragma unroll
  for (int d = 0; d < 4; ++d)
#pragma unroll
    for (int r = 0; r < 16; ++r) o[d][r] = 0.f;
  bf16x8 qr[8];
  { const bf16_t* Qw = Q0 + (size_t)(wid * 32 + r32) * ldq + hi * 8;
#pragma unroll
    for (int d0 = DLO; d0 < DHI; ++d0) qr[d0] = *(const bf16x8*)(Qw + d0 * 16); }
  const int ksrc = (tid >> 4) * ldk + (((tid & 15) ^ ((tid >> 4) & 7)) << 3);
  const int vkk = ((tid >> 7) << 3) | ((tid & 31) >> 2), vk = (vkk & ~0xC) | ((vkk & 4) << 1) | ((vkk & 8) >> 1);
  const int vsrc = vk * ldk + (((tid >> 5) & 3) << 5) + ((tid & 3) << 3);
  const unsigned ldsw = (unsigned)wid * 1024u;
  const int vb0 = (int)(unsigned)(uintptr_t)V_lds + v_rd_base(lane);
  const int wrow0 = qpos0 + wid * 32, trow = wrow0 + r32;
  float m_reg = -1e30f, l_reg = 0.f, R = 1.0f;
  ATT_LAS int* dflag = (ATT_LAS int*)(lds + SCR_OFF + 8 * 64 * 4) + (par & 1) * 8;
  bool wdone = false;
  if (STRICT && lane == 0) dflag[wid] = -1;
#define ATT_DMA(t) do { const bf16_t* kg_ = Kb + (size_t)(64 * (t)) * ldk + ksrc; const bf16_t* vg_ = Vb + (size_t)(64 * (t)) * ldk + vsrc; const int b_ = (t) & 3; \
    __builtin_amdgcn_global_load_lds((const unsigned*)kg_, (ATT_LAS unsigned*)(K_lds + b_ * SHM_K + ldsw), 16, 0, 0); \
    __builtin_amdgcn_global_load_lds((const unsigned*)(kg_ + 32 * ldk), (ATT_LAS unsigned*)(K_lds + b_ * SHM_K + ldsw + 8192), 16, 0, 0); \
    __builtin_amdgcn_global_load_lds((const unsigned*)vg_, (ATT_LAS unsigned*)(V_lds + b_ * SHM_V + ldsw), 16, 0, 0); \
    __builtin_amdgcn_global_load_lds((const unsigned*)(vg_ + 32 * ldk), (ATT_LAS unsigned*)(V_lds + b_ * SHM_V + ldsw + 8192), 16, 0, 0); } while (0)
  ATT_DMA(nt - 1); ATT_DMA(nt - 2); asm volatile("s_waitcnt vmcnt(0)" ::: "memory"); __syncthreads();
  for (int jj = nt - 1; jj >= 1; jj -= 2) {
   if (jj >= 3) { ATT_DMA(jj - 2); ATT_DMA(jj - 3); }
#ifdef ATT_STAGGER
   if (wid >= 4) __builtin_amdgcn_s_sleep(ATT_STAGGER);
#endif
#pragma unroll
   for (int sub = 0; sub < 2; ++sub) {
    const int j = jj - sub, b = j & 3, kbase = 64 * j;
    bool skip = false, needmask = false;
    if (CAUSAL) { skip = kbase > wrow0 + 31; needmask = kbase + 63 > wrow0; }
    if (STRICT) { skip = kbase >= wrow0 + 31; needmask = kbase + 63 >= wrow0; }
    if (!skip && !wdone) {
      f32x16 p0, p1; bf16x8 pa0, pa1, pa2, pa3;
      qkt<DLO, DHI>(p0, p1, K_lds + b * SHM_K, qr, r32, hi);
#ifdef ATT_VPRE
      VFrag vfa, vfb; ATT_SBAR(); pv_pre(vfa, vfb, vb0 + b * SHM_V); ATT_SBAR();
#endif
      const int dd = trow - kbase - 4 * hi;
      if (SOFT) {
        if (CAUSAL && needmask) {
#pragma unroll
          for (int r = 0; r < 16; ++r) { const int cr = (r & 3) + 8 * (r >> 2); if (cr > dd) p0[r] = -INFINITY; if (cr + 32 > dd) p1[r] = -INFINITY; }
        }
        float pmax = p0[0];
#pragma unroll
        for (int r = 1; r < 16; ++r) pmax = fmaxf(pmax, p0[r]);
#pragma unroll
        for (int r = 0; r < 16; ++r) pmax = fmaxf(pmax, p1[r]);
        { auto rr = __builtin_amdgcn_permlane32_swap(__float_as_uint(pmax), __float_as_uint(pmax), false, false); pmax = fmaxf(__uint_as_float(rr[0]), __uint_as_float(rr[1])); }
        float mn, alpha;
        if (__builtin_expect(__all(pmax - m_reg <= 11.5f), 1)) { mn = m_reg; alpha = 1.f; }
        else { mn = fmaxf(m_reg, pmax); alpha = __builtin_amdgcn_exp2f(m_reg - mn); m_reg = mn; }
#pragma unroll
        for (int r = 0; r < 16; ++r) { p0[r] = __builtin_amdgcn_exp2f(p0[r] - mn); p1[r] = __builtin_amdgcn_exp2f(p1[r] - mn); }
        float ps = 0.f;
#pragma unroll
        for (int r = 0; r < 16; ++r) ps += p0[r];
#pragma unroll
        for (int r = 0; r < 16; ++r) ps += p1[r];
        { auto rr = __builtin_amdgcn_permlane32_swap(__float_as_uint(ps), __float_as_uint(ps), false, false); ps = __uint_as_float(rr[0]) + __uint_as_float(rr[1]); }
        l_reg = l_reg * alpha + ps;
        if (__any(alpha < 1.f)) { if (hi == 0) al_l[r32] = alpha; asm volatile("s_waitcnt lgkmcnt(0)" ::: "memory");
#pragma unroll
          for (int r = 0; r < 16; ++r) { const float a = al_l[crow(r, hi)];
#pragma unroll
            for (int d = 0; d < 4; ++d) o[d][r] *= a; }
          asm volatile("s_waitcnt lgkmcnt(0)" ::: "memory"); }
      } else {
        f32x16 q0, q1;
#pragma unroll
        for (int r = 0; r < 16; ++r) {
          { const float u = fmaxf(p0[r], -80.f), s = __builtin_amdgcn_exp2f(-u), rc = __builtin_amdgcn_rcpf(1.0f + s); p0[r] = rc; q0[r] = s * rc; }
          { const float u = fmaxf(p1[r], -80.f), s = __builtin_amdgcn_exp2f(-u), rc = __builtin_amdgcn_rcpf(1.0f + s); p1[r] = rc; q1[r] = s * rc; } }
        if (needmask) {
#pragma unroll
          for (int r = 0; r < 16; ++r) { const int cr = (r & 3) + 8 * (r >> 2);
            if (!(cr < dd)) { p0[r] = 0.f; q0[r] = 1.f; } if (!(cr + 32 < dd)) { p1[r] = 0.f; q1[r] = 1.f; } }
        }
        float tot[8];
#pragma unroll
        for (int c = 0; c < 4; ++c) { tot[c] = (q0[4 * c] * q0[4 * c + 1]) * (q0[4 * c + 2] * q0[4 * c + 3]); tot[4 + c] = (q1[4 * c] * q1[4 * c + 1]) * (q1[4 * c + 2] * q1[4 * c + 3]); }
        float run = R;
#pragma unroll
        for (int c = 7; c >= 0; --c) {
          auto rr = __builtin_amdgcn_permlane32_swap(__float_as_uint(tot[c]), __float_as_uint(tot[c]), false, false);
          const float Tlo = __uint_as_float(rr[0]), Thi = __uint_as_float(rr[1]);
          const float r1 = run, r0 = r1 * Thi;
          const float e3 = hi ? r1 : r0;
          if (c < 4) { const float e2 = e3 * q0[4 * c + 3], e1 = e2 * q0[4 * c + 2], e0 = e1 * q0[4 * c + 1];
            p0[4 * c + 3] *= e3; p0[4 * c + 2] *= e2; p0[4 * c + 1] *= e1; p0[4 * c] *= e0; }
          else { const int cc = c - 4; const float e2 = e3 * q1[4 * cc + 3], e1 = e2 * q1[4 * cc + 2], e0 = e1 * q1[4 * cc + 1];
            p1[4 * cc + 3] *= e3; p1[4 * cc + 2] *= e2; p1[4 * cc + 1] *= e1; p1[4 * cc] *= e0; }
          run = r0 * Tlo;
        }
        R = run;
      }
      pack_p(p0, p1, pa0, pa1, pa2, pa3);
#ifdef ATT_VPRE
      pv_post(o, vfa, vfb, vb0 + b * SHM_V, pa0, pa1, pa2, pa3);
#else
      pv_d0(o, vb0 + b * SHM_V, pa0, pa1, pa2, pa3);
#endif
      if (STRICT) { if (__all(R < SB_EPS)) { wdone = true; if (lane == 0) dflag[wid] = j; } }
    }
   }
    asm volatile("s_waitcnt vmcnt(0)" ::: "memory");
    __syncthreads();
    if (STRICT) { bool all = true;
#pragma unroll
      for (int w = 0; w < 8; ++w) all = all && (dflag[w] >= jj - 1);
      if (__builtin_amdgcn_readfirstlane((int)all)) break; }
  }
#undef ATT_DMA
  if (SOFT) {
    if (hi == 0) li_l[r32] = l_reg; asm volatile("s_waitcnt lgkmcnt(0)" ::: "memory");
#pragma unroll
    for (int r = 0; r < 16; ++r) { const float rl = __builtin_amdgcn_rcpf(li_l[crow(r, hi)]);
#pragma unroll
      for (int d = 0; d < 4; ++d) o[d][r] *= rl; }
    asm volatile("s_waitcnt lgkmcnt(0)" ::: "memory");
  }
}
template <bool NORM> __device__ __forceinline__ void store_rows(const f32x16 (&o)[4], const float* __restrict__ gain, float gscale, bf16_t* __restrict__ out, int ld, size_t cs, ATT_LAS char* lds) {
  int tl = threadIdx.x; asm volatile("" : "+v"(tl));
  const int lane = tl & 63, r32 = lane & 31, hi = lane >> 5, wid = __builtin_amdgcn_readfirstlane(tl >> 6);
  ATT_LAS char* stg = lds + (wid < 4 ? wid * 8192 : NBUF * SHM_V + (wid - 4) * 8192);
  float g[4] = {1.f, 1.f, 1.f, 1.f};
  if (NORM) {
#pragma unroll
    for (int d = 0; d < 4; ++d) g[d] = gain[32 * d + r32] * gscale; }
#pragma unroll
  for (int r = 0; r < 16; ++r) {
    float inv = 1.f;
    if (NORM) { float ss = (o[0][r] * o[0][r] + o[1][r] * o[1][r]) + (o[2][r] * o[2][r] + o[3][r] * o[3][r]);
      ss += __shfl_xor(ss, 1); ss += __shfl_xor(ss, 2); ss += __shfl_xor(ss, 4); ss += __shfl_xor(ss, 8); ss += __shfl_xor(ss, 16);
      inv = __builtin_amdgcn_rsqf(ss * (1.0f / 128.0f) + 1e-6f); }
    ATT_LAS bf16_t* rowp = (ATT_LAS bf16_t*)(stg + crow(r, hi) * 256) + r32;
#pragma unroll
    for (int d = 0; d < 4; ++d) { const float v = o[d][r] * inv * g[d]; rowp[32 * d] = (bf16_t)(cvtpk(v, v) & 0xffffu); }
  }
  asm volatile("s_waitcnt lgkmcnt(0)" ::: "memory");
#pragma unroll
  for (int k = 0; k < 8; ++k) { const int q = lane + 64 * k, row = q >> 4, piece = q & 15;
    const u32x4 w = *(const ATT_LAS u32x4*)(stg + row * 256 + piece * 16);
    *(u32x4*)(out + (size_t)row * ld + (size_t)(piece >> 3) * cs + (piece & 7) * 8) = w; }
  asm volatile("s_waitcnt lgkmcnt(0)" ::: "memory");
  __syncthreads();
}
}

constexpr int NWAVES = 8;
constexpr int S_ = 8192, D_ = 4096, FF_ = 14336, INW = 12288, MEMT = 256, XW = 512;
constexpr float NORM_EPS = 1e-6f;
#ifndef REP_P0
#define REP_P0 1
#endif
#ifndef REP_P1
#define REP_P1 1
#endif
#ifndef REP_P2
#define REP_P2 1
#endif
#ifndef REP_P3
#define REP_P3 1
#endif
#ifndef REP_P4
#define REP_P4 1
#endif
#ifndef REP_P6
#define REP_P6 1
#endif
#ifndef REP_P5
#define REP_P5 1
#endif
#ifndef CONV_P1
#define CONV_P1 0
#endif
#ifndef PG8_SP2V
#define PG8_SP2V true
#endif
#ifndef PG8_ALIGNV
#define PG8_ALIGNV true
#endif
#ifndef CONV_FP8
#define CONV_FP8 2
#endif
static_assert(CONV_FP8 >= 1, "the FFN2 gate|up GEMM reads the e4m3 rows the last pre-norm writes");
#ifndef STOP_AFTER
#define STOP_AFTER 99
#endif

constexpr size_t MiB = 1u << 20;
constexpr size_t WS_CTL = 0, CTL_ZERO_BYTES = 64 * 1024;
constexpr size_t WS_ROPE = 1 * MiB;
constexpr size_t WS_MEMN = 2 * MiB;
constexpr size_t WS_KV = 4 * MiB;
constexpr size_t WS_XQ = 5 * MiB;
constexpr size_t WS_XO = 13 * MiB;
constexpr size_t WS_SCR = 21 * MiB;
constexpr size_t WS_WQ = 53 * MiB, WS_WKV = 57 * MiB, WS_WO = 65 * MiB, WS_WOUT = 69 * MiB, WS_WIN = 101 * MiB;
constexpr size_t WS_WGU1 = 197 * MiB, WS_WD1 = 421 * MiB, WS_WGU2 = 533 * MiB, WS_WD2 = 757 * MiB;
constexpr size_t WS_XN = 869 * MiB;
constexpr size_t WS_MERGED = 933 * MiB;
constexpr size_t WS_Y = 997 * MiB;
constexpr size_t WS_XN8 = 1061 * MiB;
constexpr size_t WS_RSTD = 1 * MiB + 512 * 1024;
constexpr size_t WS_HID = 1125 * MiB;
constexpr size_t WS_SSP = 1349 * MiB;
constexpr size_t WS_END = 1351 * MiB;
constexpr int CW_BAR = 4096;

constexpr int RING_BYTES = 131072, MISC_OFF = RING_BYTES + 320, LDS_BYTES = 147456;

#define GAS __attribute__((address_space(1)))
#define LAS __attribute__((address_space(3)))
typedef unsigned short bf16;
typedef unsigned v4u __attribute__((ext_vector_type(4)));
typedef unsigned v2u __attribute__((ext_vector_type(2)));
typedef float f32x4 __attribute__((ext_vector_type(4)));
typedef float f32x2 __attribute__((ext_vector_type(2)));
typedef GAS unsigned gu32;

#define XB_TMO      128
#define XB_XCNT(j)  (256  + 64 * (j))
#define XB_XSUB(j)  (1280 + 64 * (j))
#define XB_XGEN(j)  (2304 + 64 * (j))
#define XB_TOP      3328
#define XB_TOPGEN   3392
#define XCD_BAR_WORDS 3456
#define XB_SPIN_CAP (1u << 18)

__device__ __forceinline__ unsigned xb_ld(unsigned* p)              { return __hip_atomic_load(p, __ATOMIC_RELAXED, __HIP_MEMORY_SCOPE_AGENT); }
__device__ __forceinline__ unsigned xb_add(unsigned* p, unsigned v) { return __hip_atomic_fetch_add(p, v, __ATOMIC_RELAXED, __HIP_MEMORY_SCOPE_AGENT); }
__device__ __forceinline__ unsigned xb_xcc_id() { return (unsigned)__builtin_amdgcn_s_getreg((3 << 11) | 20) & 0xFu; }
#define XB_SPIN(cond, bar) do { unsigned _sp = 0; while (cond) { __builtin_amdgcn_s_sleep(1); \
    if ((++_sp & 255u) == 0u) { if (xb_ld(&(bar)[XB_TMO])) break; if (_sp > XB_SPIN_CAP) { atomicAdd(&(bar)[XB_TMO], 1u); break; } } } } while (0)

struct XcdBarrier {
    unsigned* bar; unsigned x;
    volatile LAS unsigned* st;
};
__device__ __forceinline__ XcdBarrier xcd_barrier_post(unsigned* bar, volatile LAS unsigned* st) {
    XcdBarrier b; b.bar = bar; b.x = xb_xcc_id(); b.st = st;
    if (threadIdx.x == 0) (void)xb_add(&bar[XB_XCNT(b.x)], 1u);
    return b;
}
__device__ __forceinline__ void xcd_barrier_complete(unsigned* bar, unsigned x, unsigned& nloc, unsigned& nx) {
    const unsigned G = gridDim.x * gridDim.y * gridDim.z;
    unsigned sum, cnt, mine, sp = 0u;
    for (;;) {
        sum = 0u; cnt = 0u; mine = 0u;
#pragma unroll
        for (unsigned j = 0; j < 16; ++j) { const unsigned c = xb_ld(&bar[XB_XCNT(j)]); sum += c; cnt += (c > 0u) ? 1u : 0u; mine = (j == x) ? c : mine; }
        if (sum == G) break;
        __builtin_amdgcn_s_sleep(1);
        if ((++sp & 255u) == 0u) { if (xb_ld(&bar[XB_TMO])) break; if (sp > XB_SPIN_CAP) { atomicAdd(&bar[XB_TMO], 1u); break; } }
    }
    nloc = mine > 0u ? mine : 1u; nx = cnt > 0u ? cnt : 1u;
}
__device__ __forceinline__ void xcd_barrier(const XcdBarrier& b) {
    asm volatile("s_waitcnt vmcnt(0)" ::: "memory");
    __syncthreads();
    if (threadIdx.x == 0) {
        unsigned* bar = b.bar;
        __builtin_amdgcn_s_waitcnt(0);
        unsigned nloc = b.st[0], nx = b.st[1];
        if (nloc == 0u) { xcd_barrier_complete(bar, b.x, nloc, nx); b.st[0] = nloc; b.st[1] = nx; }
        const unsigned old = xb_add(&bar[XB_XSUB(b.x)], 1u);
        const unsigned gen = old / nloc;
        if (old + 1u == (gen + 1u) * nloc) {
            __builtin_amdgcn_fence(__ATOMIC_RELEASE, "agent");
            asm volatile("s_waitcnt vmcnt(0)" ::: "memory");
            const unsigned og = xb_add(&bar[XB_TOP], 1u);
            const unsigned tg = og / nx;
            if (og + 1u == (tg + 1u) * nx) xb_add(&bar[XB_TOPGEN], 1u);
            else XB_SPIN(xb_ld(&bar[XB_TOPGEN]) == tg, bar);
            __builtin_amdgcn_fence(__ATOMIC_ACQUIRE, "agent");
            xb_add(&bar[XB_XGEN(b.x)], 1u);
            asm volatile("s_waitcnt vmcnt(0)" ::: "memory");
        } else {
            XB_SPIN(xb_ld(&bar[XB_XGEN(b.x)]) == gen, bar);
            __builtin_amdgcn_fence(__ATOMIC_ACQUIRE, "agent");
            asm volatile("s_waitcnt vmcnt(0)" ::: "memory");
        }
    }
    __syncthreads();
}

__device__ __forceinline__ float wave_sum(float v) {
#pragma unroll
    for (int o = 1; o < 64; o <<= 1) v += __shfl_xor(v, o);
    return v;
}
__device__ __forceinline__ unsigned pkbf(float lo, float hi) { unsigned r; asm volatile("v_cvt_pk_bf16_f32 %0, %1, %2" : "=v"(r) : "v"(lo), "v"(hi)); return r; }

__device__ __forceinline__ void tr_item(const float* __restrict__ W, int K, int N, bf16* __restrict__ WT, int NT, int gmul, int goff, LAS unsigned* scr, int item, int lane, const float* __restrict__ gk) {
    { int t_ = threadIdx.x; asm volatile("" : "+v"(t_)); lane = t_ & 63; }
    const int nblk = N >> 6, kb = item / nblk, nb = item - kb * nblk, k0 = kb << 6, n0 = nb << 6;
    const int q = lane >> 4, c4 = (lane & 15) * 4;
    const float* src = W + (size_t)(k0 + 2 * q) * N + n0 + c4;
    f32x4 a[8], b[8]; f32x2 gg[8];
#pragma unroll
    for (int i = 0; i < 8; ++i) { a[i] = *(const f32x4*)(src + (size_t)(8 * i) * N); b[i] = *(const f32x4*)(src + (size_t)(8 * i + 1) * N); gg[i] = *(const f32x2*)(gk + k0 + 2 * q + 8 * i); }
#pragma unroll
    for (int i = 0; i < 8; ++i) { const int kp = 4 * i + q; const f32x4 av = a[i] * gg[i][0], bv = b[i] * gg[i][1];
        scr[(c4 + 0) * 33 + kp] = pkbf(av[0], bv[0]); scr[(c4 + 1) * 33 + kp] = pkbf(av[1], bv[1]);
        scr[(c4 + 2) * 33 + kp] = pkbf(av[2], bv[2]); scr[(c4 + 3) * 33 + kp] = pkbf(av[3], bv[3]); }
    asm volatile("s_waitcnt lgkmcnt(0)" ::: "memory");
    const int c = lane & 7;
#pragma unroll
    for (int jj = 0; jj < 8; ++jj) { const int n = (lane >> 3) + 8 * jj; const LAS unsigned* s = scr + n * 33 + 4 * c;
        v4u o; o.x = s[0]; o.y = s[1]; o.z = s[2]; o.w = s[3];
        const int nn = n0 + n; const int nrow = nn + gmul * (nn & ~127) + goff;
        *(v4u*)(WT + ((size_t)kb * NT + nrow) * 64 + 8 * c) = o; }
    asm volatile("s_waitcnt lgkmcnt(0)" ::: "memory");
}
struct ConvList { const float *wd1, *wkv, *win, *wout, *wq, *wo, *wg2, *wu2, *wd2; bf16 *WD1, *WKV, *WIN, *WOUT, *WQ, *WO, *WGU2, *WD2; const float *gwin, *gwq; };
constexpr int CI_GU = (D_ / 64) * (FF_ / 64), CI_DN = CI_GU, CI_IN = (D_ / 64) * (INW / 64), CI_OUT = (D_ / 64) * (D_ / 64), CI_Q = (D_ / 64) * (XW / 64), CI_KV = (D_ / 64) * (2 * XW / 64), CI_O = (XW / 64) * (D_ / 64);
constexpr int CE_WD1 = CI_DN, CE_WKV = CE_WD1 + CI_KV, CE_WIN = CE_WKV + CI_IN, CE_WOUT = CE_WIN + CI_OUT, CE_WQ = CE_WOUT + CI_Q, CE_WO = CE_WQ + CI_O, CE_WGU2 = CE_WO + 2 * CI_GU, CE_ALL = CE_WGU2 + CI_DN;
constexpr int CW_CONV = 2048;
struct ConvJob { const float* W; bf16* WT; const float* gk; int K, N, gmul, goff, item; };
__device__ __forceinline__ ConvJob conv_decode(const ConvList& L, int gi) {
    ConvJob j; j.gmul = 0; j.goff = 0; j.gk = nullptr; int r = gi;
    if (r < CE_WD1) { j.W = L.wd1; j.WT = L.WD1; j.K = FF_; j.N = D_; }
    else if (r < CE_WKV) { r -= CE_WD1; j.W = L.wkv; j.WT = L.WKV; j.K = D_; j.N = 2 * XW; }
    else if (r < CE_WIN) { r -= CE_WKV; j.W = L.win; j.WT = L.WIN; j.K = D_; j.N = INW; j.gk = L.gwin; }
    else if (r < CE_WOUT) { r -= CE_WIN; j.W = L.wout; j.WT = L.WOUT; j.K = D_; j.N = D_; }
    else if (r < CE_WQ) { r -= CE_WOUT; j.W = L.wq; j.WT = L.WQ; j.K = D_; j.N = XW; j.gk = L.gwq; }
    else if (r < CE_WO) { r -= CE_WQ; j.W = L.wo; j.WT = L.WO; j.K = XW; j.N = D_; }
    else if (r < CE_WO + CI_GU) { r -= CE_WO; j.W = L.wg2; j.WT = L.WGU2; j.K = D_; j.N = FF_; j.gmul = 1; }
    else if (r < CE_WGU2) { r -= CE_WO + CI_GU; j.W = L.wu2; j.WT = L.WGU2; j.K = D_; j.N = FF_; j.gmul = 1; j.goff = 128; }
    else { r -= CE_WGU2; j.W = L.wd2; j.WT = L.WD2; j.K = FF_; j.N = D_; }
    j.item = r; return j;
}
__device__ __forceinline__ void tr_load(const ConvJob& j, f32x4 (&a)[8], f32x4 (&b)[8], f32x2 (&gg)[8], int lane) {
    const int nblk = j.N >> 6, kb = j.item / nblk, nb = j.item - kb * nblk, k0 = kb << 6, n0 = nb << 6;
    const int q = lane >> 4, c4 = (lane & 15) * 4;
    const float* src = j.W + (size_t)(k0 + 2 * q) * j.N + n0 + c4;
#pragma unroll
    for (int i = 0; i < 8; ++i) { a[i] = __builtin_nontemporal_load((const f32x4*)(src + (size_t)(8 * i) * j.N)); b[i] = __builtin_nontemporal_load((const f32x4*)(src + (size_t)(8 * i + 1) * j.N)); }
    if (j.gk) {
#pragma unroll
        for (int i = 0; i < 8; ++i) gg[i] = *(const f32x2*)(j.gk + k0 + 2 * q + 8 * i); }
    else {
#pragma unroll
        for (int i = 0; i < 8; ++i) gg[i] = (f32x2){1.0f, 1.0f}; }
}
__device__ __forceinline__ void tr_finish(const ConvJob& j, const f32x4 (&a)[8], const f32x4 (&b)[8], const f32x2 (&gg)[8], LAS unsigned* scr, int lane) {
    const int nblk = j.N >> 6, kb = j.item / nblk, nb = j.item - kb * nblk, k0 = kb << 6, n0 = nb << 6;
    const int q = lane >> 4, c4 = (lane & 15) * 4;
#pragma unroll
    for (int i = 0; i < 8; ++i) { const int kp = 4 * i + q; const f32x4 av = a[i] * gg[i][0], bv = b[i] * gg[i][1];
        scr[(c4 + 0) * 33 + kp] = pkbf(av[0], bv[0]); scr[(c4 + 1) * 33 + kp] = pkbf(av[1], bv[1]);
        scr[(c4 + 2) * 33 + kp] = pkbf(av[2], bv[2]); scr[(c4 + 3) * 33 + kp] = pkbf(av[3], bv[3]); }
    asm volatile("s_waitcnt lgkmcnt(0)" ::: "memory");
    const int c = lane & 7;
#pragma unroll
    for (int jj = 0; jj < 8; ++jj) { const int n = (lane >> 3) + 8 * jj; const LAS unsigned* s = scr + n * 33 + 4 * c;
        v4u o; o.x = s[0]; o.y = s[1]; o.z = s[2]; o.w = s[3];
        const int nn = n0 + n; const int nrow = nn + j.gmul * (nn & ~127) + j.goff;
        __builtin_nontemporal_store(o, (v4u*)(j.WT + ((size_t)kb * (j.N << j.gmul) + nrow) * 64 + 8 * c)); }
    asm volatile("s_waitcnt lgkmcnt(0)" ::: "memory");
}
__device__ __forceinline__ unsigned pk4_fp8(float a, float b, float c, float d) { int w = __builtin_amdgcn_cvt_pk_fp8_f32(a, b, 0, false); w = __builtin_amdgcn_cvt_pk_fp8_f32(c, d, w, true); return (unsigned)w; }
__device__ __forceinline__ void tr_item8(const ConvJob& j, LAS unsigned* scr, int lane) {
    const int nblk = j.N >> 6, kb = j.item / nblk, nb = j.item - kb * nblk, k0 = kb << 6, n0 = nb << 6;
    const int q = lane >> 4, c4 = (lane & 15) * 4;
    const float* src = j.W + (size_t)(k0 + 4 * q) * j.N + n0 + c4;
    f32x4 r[4][4];
#pragma unroll
    for (int i = 0; i < 4; ++i)
#pragma unroll
        for (int e = 0; e < 4; ++e) r[i][e] = __builtin_nontemporal_load((const f32x4*)(src + (size_t)(16 * i + e) * j.N));
#pragma unroll
    for (int i = 0; i < 4; ++i) { const int kq = 4 * i + q;
#pragma unroll
        for (int jn = 0; jn < 4; ++jn) scr[(c4 + jn) * 17 + kq] = pk4_fp8(r[i][0][jn] * 256.0f, r[i][1][jn] * 256.0f, r[i][2][jn] * 256.0f, r[i][3][jn] * 256.0f); }
    asm volatile("s_waitcnt lgkmcnt(0)" ::: "memory");
    const int c = lane & 3;
#pragma unroll
    for (int jj = 0; jj < 4; ++jj) { const int n = (lane >> 2) + 16 * jj; const LAS unsigned* sp = scr + n * 17 + 4 * c;
        v4u o; o.x = sp[0]; o.y = sp[1]; o.z = sp[2]; o.w = sp[3];
        const int nn = n0 + n; const int nrow = nn + j.gmul * (nn & ~127) + j.goff;
        __builtin_nontemporal_store(o, (v4u*)((unsigned char*)j.WT + ((size_t)(kb >> 1) * (j.N << j.gmul) + nrow) * 128 + (kb & 1) * 64 + 16 * c)); }
    asm volatile("s_waitcnt lgkmcnt(0)" ::: "memory");
}
constexpr int CONV_CHUNK = 32, CONV_PER_WAVE = CONV_CHUNK / NWAVES;
static_assert(CE_WO % CONV_CHUNK == 0 && CE_WGU2 % CONV_CHUNK == 0, "a wave's items are all of one kind");
static_assert(CE_ALL % CONV_CHUNK == 0, "whole chunks");
__device__ __forceinline__ void conv_pull(const ConvList& L, gu32* ctr, int limit, gu32* stop, volatile LAS unsigned* slot, LAS unsigned* scr, int tid, int wave, int lane) {
    { int t_ = threadIdx.x; asm volatile("" : "+v"(t_)); tid = t_; lane = t_ & 63; }
    for (int iter = 0;; ++iter) {
        if (tid == 0) { unsigned b = 0xffffffffu;
            const bool halt = stop != nullptr && __hip_atomic_load(stop, __ATOMIC_RELAXED, __HIP_MEMORY_SCOPE_AGENT) != 0u;
            if (!halt && (int)__hip_atomic_load(ctr, __ATOMIC_RELAXED, __HIP_MEMORY_SCOPE_AGENT) < limit) b = __hip_atomic_fetch_add(ctr, (unsigned)CONV_CHUNK, __ATOMIC_RELAXED, __HIP_MEMORY_SCOPE_AGENT); slot[iter & 1] = b; }
        __syncthreads();
        const unsigned base = slot[iter & 1];
        if (base >= (unsigned)CE_ALL) break;
        const int g0 = (int)base + wave * CONV_PER_WAVE;
        if (CONV_FP8 && g0 >= CE_WO && g0 < (CONV_FP8 >= 2 ? CE_ALL : CE_WGU2)) {
#pragma unroll 1
            for (int k = 0; k < CONV_PER_WAVE; ++k) { const ConvJob j8 = conv_decode(L, g0 + k); tr_item8(j8, scr, lane); }
            continue; }
        f32x4 a0[8], b0[8], a1[8], b1[8]; f32x2 gg0[8], gg1[8];
        ConvJob j0 = conv_decode(L, g0), j1;
        tr_load(j0, a0, b0, gg0, lane);
#pragma unroll 1
        for (int k = 0; k < CONV_PER_WAVE; k += 2) {
            j1 = conv_decode(L, g0 + k + 1); tr_load(j1, a1, b1, gg1, lane);
            tr_finish(j0, a0, b0, gg0, scr, lane);
            if (k + 2 < CONV_PER_WAVE) { j0 = conv_decode(L, g0 + k + 2); tr_load(j0, a0, b0, gg0, lane); }
            tr_finish(j1, a1, b1, gg1, scr, lane);
        }
    }
    __syncthreads();
}
#define NR_LD(p, j) (((const f32x4*)((p) + 256 * (j)))[lane])
#define NR_FENCE() asm volatile("" ::: "memory")
template <bool HAS_Y, bool WRITE_H, bool WRITE_XN, bool RAW = false>
__device__ __forceinline__ void norm_row(const float* hin, const float* __restrict__ y, float cy, const float* __restrict__ g_post, float* hout,
                                         const float* __restrict__ g_pre, bf16* __restrict__ xn, size_t xcs, int lane, float* rstd = nullptr) {
    f32x4 hv[16];
    if (HAS_Y) {
    { int t_ = threadIdx.x; asm volatile("" : "+v"(t_)); lane = t_ & 63; }
        float ss = 0.f;
#pragma unroll
        for (int c = 0; c < 2; ++c) { f32x4 yv[8];
#pragma unroll
            for (int j = 0; j < 8; ++j) yv[j] = NR_LD(y, 8 * c + j);
#pragma unroll
            for (int j = 0; j < 8; ++j) ss += (yv[j][0] * yv[j][0] + yv[j][1] * yv[j][1]) + (yv[j][2] * yv[j][2] + yv[j][3] * yv[j][3]);
            NR_FENCE(); }
        const float ry = cy * __builtin_amdgcn_rsqf(wave_sum(ss) * (1.0f / 4096.0f) + NORM_EPS);
#pragma unroll
        for (int c = 0; c < 4; ++c) { f32x4 yv[4], gv[4];
#pragma unroll
            for (int j = 0; j < 4; ++j) { hv[4 * c + j] = NR_LD(hin, 4 * c + j); yv[j] = NR_LD(y, 4 * c + j); gv[j] = NR_LD(g_post, 4 * c + j); }
#pragma unroll
            for (int j = 0; j < 4; ++j) { hv[4 * c + j] = hv[4 * c + j] + (yv[j] * ry) * gv[j]; if (WRITE_H) ((f32x4*)(hout + 256 * (4 * c + j)))[lane] = hv[4 * c + j]; }
            NR_FENCE(); }
    } else {
#pragma unroll
        for (int c = 0; c < 2; ++c) {
#pragma unroll
            for (int j = 0; j < 8; ++j) hv[8 * c + j] = NR_LD(hin, 8 * c + j);
            NR_FENCE(); }
        if (WRITE_H) {
#pragma unroll
            for (int j = 0; j < 16; ++j) ((f32x4*)(hout + 256 * j))[lane] = hv[j]; }
    }
    if (WRITE_XN) {
        float ss = 0.f;
#pragma unroll
        for (int j = 0; j < 16; ++j) ss += (hv[j][0] * hv[j][0] + hv[j][1] * hv[j][1]) + (hv[j][2] * hv[j][2] + hv[j][3] * hv[j][3]);
        const float rh = __builtin_amdgcn_rsqf(wave_sum(ss) * (1.0f / 4096.0f) + NORM_EPS);
        if (RAW) { if (lane == 0) *rstd = rh; }
#pragma unroll
        for (int c = 0; c < 4; ++c) { f32x4 gv[4];
            if (!RAW) {
#pragma unroll
            for (int j = 0; j < 4; ++j) gv[j] = NR_LD(g_pre, 4 * c + j); }
#pragma unroll
            for (int j = 0; j < 4; ++j) { f32x4 v = hv[4 * c + j]; if (!RAW) v = (v * rh) * gv[j]; v2u w; w.x = pkbf(v[0], v[1]); w.y = pkbf(v[2], v[3]); *(v2u*)(xn + (size_t)(4 * (4 * c + j) + (lane >> 4)) * xcs + 4 * (lane & 15)) = w; }
            NR_FENCE(); }
    }
}

template <bool OUT32, bool FP8X>
__device__ __forceinline__ void norm_row2(bf16* xh, size_t xcs, const bf16* __restrict__ y, const float* __restrict__ ssp, float cy, const float* __restrict__ g_post, float* hout32,
                                          const float* __restrict__ g_pre, unsigned char* xn8, size_t x8cs, float* rstd, int lane) {
    { int t_ = threadIdx.x; asm volatile("" : "+v"(t_)); lane = t_ & 63; }
    const float ry = cy * __builtin_amdgcn_rsqf(wave_sum(ssp[lane]) * (1.0f / 4096.0f) + NORM_EPS);
    f32x4 hv[16];
#pragma unroll
    for (int c = 0; c < 4; ++c) { v2u yb[4], hb[4]; f32x4 gv[4];
#pragma unroll
        for (int j = 0; j < 4; ++j) { hb[j] = *(const v2u*)(xh + (size_t)(4 * (4 * c + j) + (lane >> 4)) * xcs + 4 * (lane & 15));
            yb[j] = ((const v2u*)(y + 256 * (4 * c + j)))[lane]; gv[j] = NR_LD(g_post, 4 * c + j); }
#pragma unroll
        for (int j = 0; j < 4; ++j) { const f32x4 yv = {__uint_as_float(yb[j].x << 16), __uint_as_float(yb[j].x & 0xffff0000u), __uint_as_float(yb[j].y << 16), __uint_as_float(yb[j].y & 0xffff0000u)};
            const f32x4 h0 = {__uint_as_float(hb[j].x << 16), __uint_as_float(hb[j].x & 0xffff0000u), __uint_as_float(hb[j].y << 16), __uint_as_float(hb[j].y & 0xffff0000u)};
            hv[4 * c + j] = h0 + (yv * ry) * gv[j];
            if (OUT32) ((f32x4*)(hout32 + 256 * (4 * c + j)))[lane] = hv[4 * c + j];
            else { v2u w; w.x = pkbf(hv[4 * c + j][0], hv[4 * c + j][1]); w.y = pkbf(hv[4 * c + j][2], hv[4 * c + j][3]); *(v2u*)(xh + (size_t)(4 * (4 * c + j) + (lane >> 4)) * xcs + 4 * (lane & 15)) = w; } }
        NR_FENCE(); }
    if (!OUT32) {
        float ss = 0.f;
#pragma unroll
        for (int j = 0; j < 16; ++j) ss += (hv[j][0] * hv[j][0] + hv[j][1] * hv[j][1]) + (hv[j][2] * hv[j][2] + hv[j][3] * hv[j][3]);
        const float rh = __builtin_amdgcn_rsqf(wave_sum(ss) * (1.0f / 4096.0f) + NORM_EPS);
        if (!FP8X) { if (lane == 0) *rstd = rh; }
        else {
#pragma unroll
        for (int c = 0; c < 4; ++c) { f32x4 gv[4];
#pragma unroll
            for (int j = 0; j < 4; ++j) gv[j] = NR_LD(g_pre, 4 * c + j);
#pragma unroll
            for (int j = 0; j < 4; ++j) { const f32x4 v = (hv[4 * c + j] * rh) * gv[j];
                *(unsigned*)(xn8 + (size_t)(2 * (4 * c + j) + (lane >> 5)) * x8cs + 4 * (lane & 31)) = pk4_fp8(v[0], v[1], v[2], v[3]); }
            NR_FENCE(); } }
    }
}
__device__ __forceinline__ void sincos_d(float ang, float& sn, float& cs) {
    const double a = (double)ang, k = __builtin_rint(a * 0.15915494309189535);
    double r = __builtin_fma(-k, 6.283185307179586, a); r = __builtin_fma(-k, 2.4492935982947064e-16, r);
    const double z = r * r;
    double sp = 1.0 / 1.0888869450418352e28;
    sp = sp * z - 1.0 / 1.5511210043330986e25;
    sp = sp * z + 1.0 / 2.5852016738884978e22;
    sp = sp * z - 1.0 / 5.109094217170944e19;
    sp = sp * z + 1.0 / 1.21645100408832e17;
    sp = sp * z - 1.0 / 3.55687428096e14;
    sp = sp * z + 1.0 / 1.307674368e12;
    sp = sp * z - 1.0 / 6.2270208e9;
    sp = sp * z + 1.0 / 3.99168e7;
    sp = sp * z - 1.0 / 362880.0;
    sp = sp * z + 1.0 / 5040.0;
    sp = sp * z - 1.0 / 120.0;
    sp = sp * z + 1.0 / 6.0;
    const double s = r - r * z * sp;
    double cp = 1.0 / 4.0329146112660565e26;
    cp = cp * z - 1.0 / 6.204484017332394e23;
    cp = cp * z + 1.0 / 1.1240007277776077e21;
    cp = cp * z - 1.0 / 2.43290200817664e18;
    cp = cp * z + 1.0 / 6.402373705728e15;
    cp = cp * z - 1.0 / 2.0922789888e13;
    cp = cp * z + 1.0 / 8.71782912e10;
    cp = cp * z - 1.0 / 4.790016e8;
    cp = cp * z + 1.0 / 3628800.0;
    cp = cp * z - 1.0 / 40320.0;
    cp = cp * z + 1.0 / 720.0;
    cp = cp * z - 1.0 / 24.0;
    cp = cp * z + 0.5;
    const double c = 1.0 - z * cp;
    sn = (float)s; cs = (float)c;
}

__device__ __forceinline__ const float* karg(int i) { int ii = i; asm volatile("" : "+s"(ii)); return ((const float* const __attribute__((address_space(4)))*)__builtin_amdgcn_kernarg_segment_ptr())[ii]; }
struct Args {
    const float* in[29]; const int* pos; float* out; unsigned char* ws; float inv_freq[8]; int pad0, pad1;
};

__global__ void __launch_bounds__(NWAVES * 64, 2) mega_fwd(Args args) {
    extern __shared__ __attribute__((aligned(16))) unsigned char lds_raw[];
    LAS unsigned char* lds = (LAS unsigned char*)lds_raw;
    volatile LAS unsigned* MISC = (volatile LAS unsigned*)(lds + MISC_OFF);
    const int tid = threadIdx.x, lane = tid & 63, wave = __builtin_amdgcn_readfirstlane(tid >> 6);
    const int G = gridDim.x, bid = blockIdx.x;
    unsigned char* ws = args.ws;
    gu32* ctl = (gu32*)(ws + WS_CTL);
    for (int u = tid; u < (LDS_BYTES - RING_BYTES) / 4; u += NWAVES * 64) ((LAS unsigned*)(lds + RING_BYTES))[u] = 0u;
    __syncthreads();
    XcdBarrier bar = xcd_barrier_post((unsigned*)(ctl + CW_BAR), MISC + 8);
#define GRID_BAR() xcd_barrier(bar)

#define KARG(i) karg(i)
    float* out = args.out;
    float* ROPE = (float*)(ws + WS_ROPE); bf16* MEMN = (bf16*)(ws + WS_MEMN); bf16* KV = (bf16*)(ws + WS_KV); bf16* XQ = (bf16*)(ws + WS_XQ); bf16* XO = (bf16*)(ws + WS_XO);
    float* SCR = (float*)(ws + WS_SCR);
    bf16* WQ = (bf16*)(ws + WS_WQ); bf16* WKV = (bf16*)(ws + WS_WKV); bf16* WO = (bf16*)(ws + WS_WO); bf16* WOUT = (bf16*)(ws + WS_WOUT); bf16* WIN = (bf16*)(ws + WS_WIN);
    bf16* WGU1 = (bf16*)(ws + WS_WGU1); bf16* WD1 = (bf16*)(ws + WS_WD1); bf16* WGU2 = (bf16*)(ws + WS_WGU2); bf16* WD2 = (bf16*)(ws + WS_WD2);
    bf16* XN = (bf16*)(ws + WS_XN); bf16* MERGED = (bf16*)(ws + WS_MERGED); bf16* Y = (bf16*)(ws + WS_Y); float* SSP = (float*)(ws + WS_SSP); bf16* HID = (bf16*)(ws + WS_HID); bf16* PROJ = (bf16*)(ws + WS_HID); unsigned char* XN8 = ws + WS_XN8; float* RSTD = (float*)(ws + WS_RSTD);
    const int gw = bid * NWAVES + wave, NGW = G * NWAVES;
    gu32* cctr = ctl + CW_CONV; LAS unsigned* cscr = (LAS unsigned*)(lds + wave * 8448); volatile LAS unsigned* cslot = MISC + 16;
#define CONV_LIST() const ConvList CL{KARG(7), KARG(22), KARG(10), KARG(11), KARG(21), KARG(23), KARG(26), KARG(27), KARG(28), WD1, WKV, WIN, WOUT, WQ, WO, WGU2, WD2, KARG(8), KARG(18)}
#define CONV_DRAIN(lim) do { CONV_LIST(); conv_pull(CL, cctr, (lim), nullptr, cslot, cscr, tid, wave, lane); } while (0)
#define CONV_HELP(k) do { CONV_LIST(); conv_pull(CL, cctr, CE_ALL, ctl + CW_CONV + 64 * (k), cslot, cscr, tid, wave, lane); } while (0)
#define CONV_RAISE(k) do { if (tid == 0) __hip_atomic_store(ctl + CW_CONV + 64 * (k), 1u, __ATOMIC_RELAXED, __HIP_MEMORY_SCOPE_AGENT); } while (0)

#pragma unroll 1
    for (int rep = 0; rep < REP_P0; ++rep) {
        LAS unsigned* scr = (LAS unsigned*)(lds + wave * 8448);
        for (int it = gw; it < 2 * CI_GU; it += NGW) {
            if (it < CI_GU) tr_item(KARG(5), D_, FF_, WGU1, 2 * FF_, 1, 0, scr, it, lane, KARG(3)); else tr_item(KARG(6), D_, FF_, WGU1, 2 * FF_, 1, 128, scr, it - CI_GU, lane, KARG(3));
        }
        for (int m = gw; m < S_; m += NGW) norm_row<false, false, true, true>(KARG(0) + (size_t)m * D_, nullptr, 0.f, nullptr, nullptr, nullptr, XN + (size_t)m * 64, (size_t)S_ * 64, lane, RSTD + m);
        for (int m = gw; m < MEMT; m += NGW) norm_row<false, false, true>(KARG(1) + (size_t)m * D_, nullptr, 0.f, nullptr, nullptr, KARG(20), MEMN + (size_t)m * 64, (size_t)MEMT * 64, lane);
        for (int e = bid * (NWAVES * 64) + tid; e < S_ * 8; e += G * NWAVES * 64) { const int t = e >> 3, i = e & 7;
            const float ang = (float)args.pos[t] * args.inv_freq[i]; float sn, cs; sincos_d(ang, sn, cs); ROPE[t * 16 + i] = cs; ROPE[t * 16 + 8 + i] = sn; }
    }
    GRID_BAR();

    { const int NG1 = (G == 256 && CONV_P1) ? 240 : G;
      if (bid < NG1) {
#pragma unroll 1
        for (int rep = 0; rep < REP_P1; ++rep)
        { pg8::Gemm g{XN, WGU1, S_, 2 * FF_, D_}; pg8::StaticOrder S; S.init(S_, 2 * FF_, NG1, bid); pg8::EpiSwiGLU E{HID, FF_, S_, 1.0f, 0, RSTD};
          pg8::gemm_phase<pg8::EpiSwiGLU, pg8::StaticOrder, PG8_ALIGNV, PG8_SP2V, true>(lds, g, S, E); }
        CONV_RAISE(1);
      } else CONV_HELP(1);
      CONV_DRAIN(CE_WKV); }
    GRID_BAR();
#pragma unroll 1
    for (int rep = 0; rep < REP_P2; ++rep)
    { pg8::Gemm g{HID, WD1, S_, D_, FF_}; pg8::StaticOrder S; S.init(S_, D_, G, bid); pg8::EpiBf16SS E{Y, D_, SSP, 1.0f};
      pg8::gemm_phase<pg8::EpiBf16SS, pg8::StaticOrder, PG8_ALIGNV, PG8_SP2V, true>(lds, g, S, E); }
    GRID_BAR();
    for (int m = gw; m < S_; m += NGW) norm_row2<false, false>(XN + (size_t)m * 64, (size_t)S_ * 64, Y + (size_t)m * D_, SSP + (size_t)m * 64, 0.5f, KARG(4), nullptr, nullptr, nullptr, 0, RSTD + m, lane);
    if (STOP_AFTER <= 3) return;
    CONV_DRAIN(CE_WIN);
    GRID_BAR();
#pragma unroll 1
    for (int rep = 0; rep < REP_P4; ++rep)
    { pg8::Gemm g{XN, WIN, S_, INW, D_}; pg8::StaticOrder S; S.init(S_, INW, G, bid); pg8::EpiProj E{PROJ, S_, ROPE, RSTD};
      pg8::gemm_phase<pg8::EpiProj, pg8::StaticOrder, PG8_ALIGNV, PG8_SP2V, true>(lds, g, S, E); }
    GRID_BAR();
    {
        float lam;
        { const float a = wave_sum(KARG(12)[lane] * KARG(13)[lane]), b = wave_sum(KARG(14)[lane] * KARG(15)[lane]); lam = __expf(a) - __expf(b) + 0.2f; }
        LAS char* alds = (LAS char*)lds;
        for (int it = bid; it < 256 * REP_P5; it += G) {
            const int h = it & 15, y = (it >> 4) & 15;
#if !defined(ATT_TEST) || ATT_TEST == 1
            for (int s = 0; s < 2; ++s) { const int qt = s ? y : 31 - y, q0 = 256 * qt, nt = 4 * (qt + 1);
                int tl = threadIdx.x; asm volatile("" : "+v"(tl)); const int r32 = tl & 31, hi = (tl >> 5) & 1;
                att::f32x16 o[4];
                att::attn_core<att::M_SOFT_B>(PROJ + ((size_t)(0 * 16 + h) * S_ + q0) * 128, 128, PROJ + ((size_t)(1 * 16 + h) * S_) * 128, PROJ + ((size_t)(2 * 16 + h) * S_) * 128, 128, q0, nt, alds, o, 0);
                int tsp = threadIdx.x; asm volatile("" : "+v"(tsp));
                f32x4* sp = (f32x4*)(SCR + (size_t)bid * (64 * 512) + tsp * 64);
#pragma unroll
                for (int d = 0; d < 4; ++d)
#pragma unroll
                    for (int k = 0; k < 4; ++k) sp[d * 4 + k] = (f32x4){o[d][4 * k], o[d][4 * k + 1], o[d][4 * k + 2], o[d][4 * k + 3]};
                att::attn_core<att::M_SOFT_A>(PROJ + ((size_t)(0 * 16 + h) * S_ + q0) * 128, 128, PROJ + ((size_t)(1 * 16 + h) * S_) * 128, PROJ + ((size_t)(2 * 16 + h) * S_) * 128, 128, q0, nt, alds, o, 0);
#pragma unroll
                for (int d = 0; d < 4; ++d)
#pragma unroll
                    for (int k = 0; k < 4; ++k) { const f32x4 v = sp[d * 4 + k];
#pragma unroll
                        for (int e = 0; e < 4; ++e) o[d][4 * k + e] -= lam * v[e]; }
                att::store_rows<true>(o, KARG(16), 0.8f, MERGED + ((size_t)(2 * h) * S_ + q0 + wave * 32) * 64, 64, (size_t)S_ * 64, alds);
            }
#endif
#if !defined(ATT_TEST) || ATT_TEST == 2
            for (int s = 0; s < 2; ++s) { const int qt = s ? y : 31 - y, q0 = 256 * qt, nt = 4 * (qt + 1);
                int tl = threadIdx.x; asm volatile("" : "+v"(tl)); const int r32 = tl & 31, hi = (tl >> 5) & 1;
                att::f32x16 o[4];
                att::attn_core<att::M_SB>(PROJ + ((size_t)(3 * 16 + h) * S_ + q0) * 128, 128, PROJ + ((size_t)(4 * 16 + h) * S_) * 128, PROJ + ((size_t)(5 * 16 + h) * S_) * 128, 128, q0, nt, alds, o, s);
                att::store_rows<true>(o, KARG(17), 1.0f, MERGED + ((size_t)(32 + 2 * h) * S_ + q0 + wave * 32) * 64, 64, (size_t)S_ * 64, alds);
            }
#endif
        }
    }
    CONV_DRAIN(CE_WOUT);
    GRID_BAR();
#pragma unroll 1
    for (int rep = 0; rep < REP_P6; ++rep)
    { pg8::Gemm g{MERGED, WOUT, S_, D_, D_}; pg8::StaticOrder S; S.init(S_, D_, G, bid); pg8::EpiBf16SS E{Y, D_, SSP, 1.0f};
      pg8::gemm_phase<pg8::EpiBf16SS, pg8::StaticOrder, PG8_ALIGNV, PG8_SP2V, true>(lds, g, S, E); }
    GRID_BAR();
    for (int m = gw; m < S_; m += NGW) norm_row2<false, false>(XN + (size_t)m * 64, (size_t)S_ * 64, Y + (size_t)m * D_, SSP + (size_t)m * 64, 1.0f, KARG(9), nullptr, nullptr, nullptr, 0, RSTD + m, lane);
    if (STOP_AFTER <= 7) return;
    CONV_DRAIN(CE_WQ);
    GRID_BAR();
    constexpr int NQU = (S_ / 256) * (XW / 256), NKVU = (2 * XW) / 256;
    if (bid < NQU) {
      { pg8::Gemm g{XN, WQ, S_, XW, D_}; pg8::StaticOrder S; S.init(S_, XW, G, bid); pg8::EpiBf16S E{XQ, XW, 0.08838834764831845f * pg8::LOG2E, RSTD};
        pg8::gemm_phase<pg8::EpiBf16S, pg8::StaticOrder, false, true, true>(lds, g, S, E); }
      CONV_RAISE(2);
    } else if (bid < NQU + NKVU && G >= NQU + NKVU) {
      pg8::Gemm g{MEMN, WKV, MEMT, 2 * XW, D_}; pg8::RowOrder S{NKVU, NKVU, bid - NQU}; pg8::EpiBf16S E{KV, 2 * XW, 1.0f, nullptr};
      pg8::gemm_phase<pg8::EpiBf16S, pg8::RowOrder, false, true, true>(lds, g, S, E);
    } else CONV_HELP(2);
    if (G < NQU + NKVU && bid == 0) { pg8::Gemm g{MEMN, WKV, MEMT, 2 * XW, D_}; pg8::RowOrder S{NKVU, 1, 0}; pg8::EpiBf16S E{KV, 2 * XW, 1.0f, nullptr};
      pg8::gemm_phase<pg8::EpiBf16S, pg8::RowOrder, false, true, true>(lds, g, S, E); }
    GRID_BAR();
    if (bid < 128) {
        const int r32 = lane & 31, hi = lane >> 5; LAS char* alds = (LAS char*)lds;
        for (int it = bid; it < 128; it += G) { const int h = it & 3, q0 = 256 * (it >> 2);
            att::f32x16 o[4];
            att::attn_core<att::M_DENSE>(XQ + (size_t)q0 * XW + h * 128, XW, KV + h * 128, KV + XW + h * 128, 2 * XW, 0, 4, alds, o, 0);
            att::store_rows<false>(o, nullptr, 1.0f, XO + ((size_t)(2 * h) * S_ + q0 + wave * 32) * 64, 64, (size_t)S_ * 64, alds); }
        if (bid + G >= 128) CONV_RAISE(3);
    } else CONV_HELP(3);
    CONV_DRAIN(CE_WO);
    GRID_BAR();
    { pg8::Gemm g{XO, WO, S_, D_, XW}; pg8::StaticOrder S; S.init(S_, D_, G, bid); pg8::EpiBf16SS E{Y, D_, SSP, 1.0f};
      pg8::gemm_phase<pg8::EpiBf16SS, pg8::StaticOrder, PG8_ALIGNV, PG8_SP2V, true>(lds, g, S, E); }
    GRID_BAR();
    for (int m = gw; m < S_; m += NGW) norm_row2<false, true>(XN + (size_t)m * 64, (size_t)S_ * 64, Y + (size_t)m * D_, SSP + (size_t)m * 64, 1.0f, KARG(19), nullptr, KARG(24), XN8 + (size_t)m * 128, (size_t)S_ * 128, nullptr, lane);
    if (STOP_AFTER <= 11) return;
    CONV_DRAIN(CE_WGU2);
    GRID_BAR();
    { pg8::Gemm g{(const bf16*)XN8, WGU2, S_, 2 * FF_, D_}; pg8::StaticOrder S; S.init(S_, 2 * FF_, G, bid); pg8::EpiSwiGLU E{HID, FF_, S_, 0.00390625f, CONV_FP8 >= 2, nullptr};
      pg8::gemm_phase<pg8::EpiSwiGLU, pg8::StaticOrder, PG8_ALIGNV, PG8_SP2V, true, CONV_FP8 != 0>(lds, g, S, E); }
    CONV_DRAIN(CE_ALL);
    GRID_BAR();
    { pg8::Gemm g{HID, WD2, S_, D_, FF_}; pg8::StaticOrder S; S.init(S_, D_, G, bid); pg8::EpiBf16SS E{Y, D_, SSP, CONV_FP8 >= 2 ? 0.00390625f : 1.0f};
      pg8::gemm_phase<pg8::EpiBf16SS, pg8::StaticOrder, PG8_ALIGNV, PG8_SP2V, true, (CONV_FP8 >= 2)>(lds, g, S, E); }
    GRID_BAR();
    for (int m = gw; m < S_; m += NGW) norm_row2<true, false>(XN + (size_t)m * 64, (size_t)S_ * 64, Y + (size_t)m * D_, SSP + (size_t)m * 64, 0.5f, KARG(25), out + (size_t)m * D_, nullptr, nullptr, 0, nullptr, lane);
}

extern "C" void kernel_launch(void* const* d_in, const int* in_sizes, int n_in, void* d_out, int out_size, void* d_ws, size_t ws_size, hipStream_t stream) {
    static int grid = 0;
    if (grid == 0) {
        if (n_in != 29 || in_sizes[0] != S_ * D_ || out_size != S_ * D_ || ws_size < WS_END) {
            fprintf(stderr, "kernel_launch: built for 29 inputs, x/out of %d floats, >= %zu bytes of workspace; got n_in %d, in0 %d, out %d, ws %zu; nothing launched\n", S_ * D_, (size_t)WS_END, n_in, n_in > 0 ? in_sizes[0] : -1, out_size, ws_size); grid = -1; return; }
        int dev = 0, cus = 0, per_cu = 0;
        if (hipGetDevice(&dev) != hipSuccess || hipDeviceGetAttribute(&cus, hipDeviceAttributeMultiprocessorCount, dev) != hipSuccess) { fprintf(stderr, "kernel_launch: device query failed\n"); grid = -1; return; }
        if (hipFuncSetAttribute((const void*)mega_fwd, hipFuncAttributeMaxDynamicSharedMemorySize, LDS_BYTES) != hipSuccess) { fprintf(stderr, "kernel_launch: hipFuncSetAttribute failed\n"); grid = -1; return; }
        if (hipOccupancyMaxActiveBlocksPerMultiprocessor(&per_cu, (const void*)mega_fwd, NWAVES * 64, LDS_BYTES) != hipSuccess || per_cu < 1) {
            fprintf(stderr, "kernel_launch: occupancy query reports %d workgroups per CU; nothing launched\n", per_cu); (void)hipGetLastError(); grid = -1; return; }
        grid = cus;
        fprintf(stderr, "kernel_launch: grid %d x %d threads, %d B LDS, occupancy query %d per CU, ws %zu\n", grid, NWAVES * 64, LDS_BYTES, per_cu, ws_size);
    }
    if (grid < 0) return;
    if (hipMemsetAsync((char*)d_ws + WS_CTL, 0, CTL_ZERO_BYTES, stream) != hipSuccess) { fprintf(stderr, "kernel_launch: hipMemsetAsync failed\n"); return; }
    Args a{};
    for (int i = 0; i < 29; ++i) a.in[i] = (const float*)d_in[i];
    a.pos = (const int*)d_in[2]; a.out = (float*)d_out; a.ws = (unsigned char*)d_ws;
    for (int i = 0; i < 8; ++i) a.inv_freq[i] = (float)pow(500000.0, -(double)(2 * i) / 16.0);
    hipLaunchKernelGGL(mega_fwd, dim3(grid), dim3(NWAVES * 64), LDS_BYTES, stream, a);
    const hipError_t le = hipPeekAtLastError();
    if (le != hipSuccess) fprintf(stderr, "kernel_launch: launch failed: %s\n", hipGetErrorName(le));
}
```
